# Optimizing an MI355X kernel written in HIP

```python
import math
import jax, jax.numpy as jnp
from jax import lax
import numpy as np

D_MODEL = 2048
BATCH = 4
SEQ = 2048
DEPTH = 2

D_MIX = D_MODEL
D_LRU = D_MIX // 2
LRU_HEADS = 4
LRU_HEAD_DIM = D_LRU // LRU_HEADS
CONV_WIDTH = 4
LRU_C = 8.0
D_POOL = D_MIX - D_LRU
POOL_WINDOWS = (2, 4, 8, 16)
N_POOL_GROUPS = len(POOL_WINDOWS)
POOL_GROUP_DIM = D_POOL // N_POOL_GROUPS
D_IN = 2 * D_LRU + D_POOL
D_FF = ((8 * D_MODEL // 3 + 255) // 256) * 256
N_EXPERTS = 8
TOP_K = 2
D_FF_EXPERT = 7 * D_MODEL // 2
N_DENSE = (DEPTH + 1) // 2
N_MOE = DEPTH // 2
DEEPNORM_ALPHA = (2 * DEPTH) ** 0.25
DEEPNORM_BETA = (8 * DEPTH) ** -0.25
LN_EPS = 1e-5

kernel_name = "hybrid_lru_pool_moe_deepnorm_adaln"


def layer_norm(x, g, b):
    xf = x.astype(jnp.float32)
    mu = jnp.mean(xf, axis=-1, keepdims=True)
    var = jnp.mean(jnp.square(xf - mu), axis=-1, keepdims=True)
    return ((xf - mu) * lax.rsqrt(var + LN_EPS) * g.astype(jnp.float32) + b.astype(jnp.float32)).astype(x.dtype)


def adaln_params(c_act, w, b):
    m = c_act @ w + b
    shift, scale, gate = jnp.split(m, 3, axis=-1)
    return shift[:, None, :], scale[:, None, :], gate[:, None, :]


def causal_depthwise_conv(x, w, b):
    S = x.shape[1]
    xp = jnp.pad(x, ((0, 0), (CONV_WIDTH - 1, 0), (0, 0)))
    y = b
    for k in range(CONV_WIDTH):
        y = y + xp[:, k:k + S] * w[k]
    return y


def rg_lru(x, w_a, b_a, w_x, b_x, lam):
    B, S, _ = x.shape
    xh = x.reshape(B, S, LRU_HEADS, LRU_HEAD_DIM)
    gate_a = jax.nn.sigmoid(jnp.einsum('bshi,hij->bshj', xh, w_a).reshape(B, S, D_LRU) + b_a)
    gate_x = jax.nn.sigmoid(jnp.einsum('bshi,hij->bshj', xh, w_x).reshape(B, S, D_LRU) + b_x)
    log_a = -LRU_C * gate_a.astype(jnp.float32) * jax.nn.softplus(-lam.astype(jnp.float32))
    a = jnp.exp(log_a)
    mult = jnp.sqrt(-jnp.expm1(2.0 * log_a))
    u = (x * gate_x).astype(jnp.float32) * mult

    def step(h, au):
        a_t, u_t = au
        h = a_t * h + u_t
        return h, h

    h0 = jnp.zeros((B, D_LRU), jnp.float32)
    _, hs = lax.scan(step, h0, (jnp.swapaxes(a, 0, 1), jnp.swapaxes(u, 0, 1)))
    return jnp.swapaxes(hs, 0, 1).astype(x.dtype)


def multiscale_pool(x, w_pool, b_pool, scale):
    B, S, _ = x.shape
    xg = x.astype(jnp.float32).reshape(B, S, N_POOL_GROUPS, POOL_GROUP_DIM)
    cs = jnp.cumsum(xg, axis=1)
    outs = []
    for gi, w in enumerate(POOL_WINDOWS):
        c_g = cs[:, :, gi]
        lag = jnp.pad(c_g, ((0, 0), (w, 0), (0, 0)))[:, :S]
        cnt = jnp.minimum(jnp.arange(1, S + 1), w).astype(jnp.float32)[None, :, None]
        outs.append((c_g - lag) / cnt - xg[:, :, gi])
    p = jnp.stack(outs, axis=2).astype(x.dtype)
    y = jnp.einsum('bsgi,gij->bsgj', p, w_pool) + b_pool
    return y.reshape(B, S, D_POOL) * scale


def hybrid_mixer(h, w_in, conv_w, conv_b, lru_wa, lru_ba, lru_wx, lru_bx, lru_lam,
                 pool_w, pool_b, pool_scale, w_out):
    z = h @ w_in
    x_lru, g_lru, x_pool = jnp.split(z, [D_LRU, 2 * D_LRU], axis=-1)
    x_lru = causal_depthwise_conv(x_lru, conv_w, conv_b)
    y_lru = rg_lru(x_lru, lru_wa, lru_ba, lru_wx, lru_bx, lru_lam) * jax.nn.gelu(g_lru)
    y_pool = multiscale_pool(x_pool, pool_w, pool_b, pool_scale)
    return jnp.concatenate([y_lru, y_pool], axis=-1) @ w_out


def swiglu(h, w_gate, w_up, w_down):
    return (jax.nn.silu(h @ w_gate) * (h @ w_up)) @ w_down


def moe_swiglu(h, w_router, w_gate, w_up, w_down):
    B, S, D = h.shape
    t = h.reshape(B * S, D)
    logits = (t @ w_router).astype(jnp.float32)
    top_v, top_i = lax.top_k(logits, TOP_K)
    probs = jax.nn.softmax(top_v, axis=-1)
    combine = jnp.einsum('nk,nke->ne', probs, jax.nn.one_hot(top_i, N_EXPERTS, dtype=jnp.float32))
    out = jnp.zeros_like(t)
    for e in range(N_EXPERTS):
        y = swiglu(t, w_gate[e], w_up[e], w_down[e])
        out = out + combine[:, e:e + 1].astype(t.dtype) * y
    return out.reshape(B, S, D)


def setup_inputs(seed: int = 0) -> dict:
    key = jax.random.key(seed)
    ks = jax.random.split(key, 26)
    n = lambda k, shape, s: jax.random.normal(k, shape, jnp.float32) * s
    u = jax.random.uniform(ks[13], (DEPTH, D_LRU), jnp.float32, 0.81, 0.998)
    p = u ** (1.0 / LRU_C)
    lru_lam = jnp.log(p) - jnp.log1p(-p)
    return {
        "x": n(ks[0], (BATCH, SEQ, D_MODEL), 1.0),
        "c": n(ks[1], (BATCH, D_MODEL), 1.0),
        "ada_w": n(ks[2], (DEPTH, 2, D_MODEL, 3 * D_MODEL), 0.1 * D_MODEL ** -0.5),
        "ada_b": n(ks[3], (DEPTH, 2, 3 * D_MODEL), 0.01),
        "ln_g": 1.0 + n(ks[4], (DEPTH, 2, D_MODEL), 0.02),
        "ln_b": n(ks[5], (DEPTH, 2, D_MODEL), 0.02),
        "mix_w_in": n(ks[6], (DEPTH, D_MODEL, D_IN), D_MODEL ** -0.5),
        "conv_w": n(ks[7], (DEPTH, CONV_WIDTH, D_LRU), CONV_WIDTH ** -0.5),
        "conv_b": n(ks[8], (DEPTH, D_LRU), 0.01),
        "lru_wa": n(ks[9], (DEPTH, LRU_HEADS, LRU_HEAD_DIM, LRU_HEAD_DIM), LRU_HEAD_DIM ** -0.5),
        "lru_ba": n(ks[10], (DEPTH, D_LRU), 0.01),
        "lru_wx": n(ks[11], (DEPTH, LRU_HEADS, LRU_HEAD_DIM, LRU_HEAD_DIM), LRU_HEAD_DIM ** -0.5),
        "lru_bx": n(ks[12], (DEPTH, D_LRU), 0.01),
        "lru_lam": lru_lam,
        "pool_w": n(ks[14], (DEPTH, N_POOL_GROUPS, POOL_GROUP_DIM, POOL_GROUP_DIM), POOL_GROUP_DIM ** -0.5),
        "pool_b": n(ks[15], (DEPTH, N_POOL_GROUPS, POOL_GROUP_DIM), 0.01),
        "pool_scale": 1.0 + n(ks[16], (DEPTH, D_POOL), 0.02),
        "mix_w_out": n(ks[17], (DEPTH, D_MIX, D_MODEL), DEEPNORM_BETA * D_MIX ** -0.5),
        "ffn_w_gate": n(ks[18], (N_DENSE, D_MODEL, D_FF), D_MODEL ** -0.5),
        "ffn_w_up": n(ks[19], (N_DENSE, D_MODEL, D_FF), D_MODEL ** -0.5),
        "ffn_w_down": n(ks[20], (N_DENSE, D_FF, D_MODEL), DEEPNORM_BETA * D_FF ** -0.5),
        "router_w": n(ks[21], (N_MOE, D_MODEL, N_EXPERTS), D_MODEL ** -0.5),
        "exp_w_gate": n(ks[22], (N_MOE, N_EXPERTS, D_MODEL, D_FF_EXPERT), D_MODEL ** -0.5),
        "exp_w_up": n(ks[23], (N_MOE, N_EXPERTS, D_MODEL, D_FF_EXPERT), D_MODEL ** -0.5),
        "exp_w_down": n(ks[24], (N_MOE, N_EXPERTS, D_FF_EXPERT, D_MODEL), DEEPNORM_BETA * D_FF_EXPERT ** -0.5),
    }


def reference(x, c, ada_w, ada_b, ln_g, ln_b, mix_w_in, conv_w, conv_b, lru_wa, lru_ba,
              lru_wx, lru_bx, lru_lam, pool_w, pool_b, pool_scale, mix_w_out,
              ffn_w_gate, ffn_w_up, ffn_w_down, router_w, exp_w_gate, exp_w_up, exp_w_down):
    c_act = jax.nn.silu(c)
    for l in range(DEPTH):
        shift, scale, gate = adaln_params(c_act, ada_w[l, 0], ada_b[l, 0])
        h = x * (1.0 + scale) + shift
        o = hybrid_mixer(h, mix_w_in[l], conv_w[l], conv_b[l], lru_wa[l], lru_ba[l],
                         lru_wx[l], lru_bx[l], lru_lam[l], pool_w[l], pool_b[l],
                         pool_scale[l], mix_w_out[l])
        x = layer_norm(DEEPNORM_ALPHA * x + (1.0 + gate) * o, ln_g[l, 0], ln_b[l, 0])
        shift, scale, gate = adaln_params(c_act, ada_w[l, 1], ada_b[l, 1])
        h = x * (1.0 + scale) + shift
        if l % 2 == 0:
            i = l // 2
            o = swiglu(h, ffn_w_gate[i], ffn_w_up[i], ffn_w_down[i])
        else:
            i = l // 2
            o = moe_swiglu(h, router_w[i], exp_w_gate[i], exp_w_up[i], exp_w_down[i])
        x = layer_norm(DEEPNORM_ALPHA * x + (1.0 + gate) * o, ln_g[l, 1], ln_b[l, 1])
    return x
```

```cpp
#include <hip/hip_runtime.h>
#include <cstdio>
#include <cstdint>

#ifndef MK_ONE_LAUNCH
#define MK_ONE_LAUNCH 1
#endif

constexpr int D = 2048, NB = 4, SEQ = 2048, M = NB * SEQ;
constexpr int DLRU = 1024, DIN = 3072, DFF = 5632, NE = 8, DFE = 7168;
constexpr int MOE_ROWS = 2 * M + NE * 256;
constexpr float LN_EPS = 1e-5f;
constexpr float DN_ALPHA = 1.41421356237309515f;
constexpr int NPHASE = 21;

#define GAS __attribute__((address_space(1)))
#define LAS __attribute__((address_space(3)))
typedef unsigned short bf16;
typedef float f32x4 __attribute__((ext_vector_type(4)));
typedef float f32x2 __attribute__((ext_vector_type(2)));
typedef unsigned u32x4 __attribute__((ext_vector_type(4)));
typedef unsigned u32x2 __attribute__((ext_vector_type(2)));
typedef short bf16x8 __attribute__((ext_vector_type(8)));

__device__ __forceinline__ unsigned cvt_pk_bf16(float lo, float hi) { unsigned r; asm volatile("v_cvt_pk_bf16_f32 %0, %1, %2" : "=v"(r) : "v"(lo), "v"(hi)); return r; }
__device__ __forceinline__ int lane_id_fresh() { int l; asm volatile("v_mbcnt_lo_u32_b32 %0, -1, 0\n\tv_mbcnt_hi_u32_b32 %0, -1, %0" : "=v"(l)); return l; }
__device__ __forceinline__ unsigned cvt_pk4_fp8(float a, float b, float c, float d) {
    a = __builtin_amdgcn_fmed3f(a, -448.f, 448.f); b = __builtin_amdgcn_fmed3f(b, -448.f, 448.f); c = __builtin_amdgcn_fmed3f(c, -448.f, 448.f); d = __builtin_amdgcn_fmed3f(d, -448.f, 448.f);
    int w = __builtin_amdgcn_cvt_pk_fp8_f32(a, b, 0, false); w = __builtin_amdgcn_cvt_pk_fp8_f32(c, d, w, true); return (unsigned)w;
}
__device__ __forceinline__ unsigned cvt_pk4_i8(float a, float b, float c, float d) {
    const int q0 = (int)__builtin_rintf(__builtin_amdgcn_fmed3f(a, -127.f, 127.f)), q1 = (int)__builtin_rintf(__builtin_amdgcn_fmed3f(b, -127.f, 127.f));
    const int q2 = (int)__builtin_rintf(__builtin_amdgcn_fmed3f(c, -127.f, 127.f)), q3 = (int)__builtin_rintf(__builtin_amdgcn_fmed3f(d, -127.f, 127.f));
    return (unsigned)(q0 & 255) | ((unsigned)(q1 & 255) << 8) | ((unsigned)(q2 & 255) << 16) | ((unsigned)q3 << 24);
}
constexpr float F8_SA1 = 16.f, F8_SB1 = 64.f, F8_SH = 8.f, F8_SB2 = 256.f;
__device__ __forceinline__ float bf_lo(unsigned w) { return __uint_as_float(w << 16); }
__device__ __forceinline__ float bf_hi(unsigned w) { return __uint_as_float(w & 0xffff0000u); }
__device__ __forceinline__ f32x4 bf4(u32x2 w) { return (f32x4){bf_lo(w.x), bf_hi(w.x), bf_lo(w.y), bf_hi(w.y)}; }
__device__ __forceinline__ float fast_sigmoid(float v) { return __builtin_amdgcn_rcpf(1.0f + __expf(-v)); }
__device__ __forceinline__ float gelu_tanh(float v) {
    const float t = 0.7978845608028654f * (v + 0.044715f * v * v * v);
    return v * fast_sigmoid(2.0f * t);
}

namespace pg8 {
#define PG8_LAS __attribute__((address_space(3)))
constexpr int BM = 256, BK = 64, HALF = 128, HTB = HALF * BK * 2  , STAGE_BYTES = 8 * HTB, NXCD = 8, WGM = 8;

__host__ __device__ __forceinline__ int lds_byte(int r, int c) { const int st = (r >> 4) * 2 + (c >> 5), rr = r & 15, cc = c & 31, ob = rr * 64 + cc * 2; return st * 1024 + (ob ^ (((ob >> 9) & 1) << 5)); }
__host__ __device__ __forceinline__ void stage_rc(int b, int& R, int& C) { const int st = b / 1024, sb = b % 1024, swz = sb ^ (((sb >> 9) & 1) << 5); R = (st >> 1) * 16 + swz / 64; C = (st & 1) * 32 + (swz % 64) / 2; }
__host__ __device__ __forceinline__ int perm32(int rho) { const int n = rho >> 4, i = rho & 15; return 8 * (i >> 2) + 4 * n + (i & 3); }

typedef int i32x4v __attribute__((ext_vector_type(4)));
typedef int i32x8v __attribute__((ext_vector_type(8)));
struct Unit { int pm, pn, ks; };
struct Gemm { int lda, ldb, K; };

struct TileOrder {
    int nM, nN, nwg, G, c;
    __device__ __forceinline__ void init_order(int nM_, int nN_, int G_, int c_) { nM = nM_; nN = nN_; nwg = nM * nN; G = G_; c = c_; }
    __device__ __forceinline__ bool next(int i, Unit& u) const {
        const long L = (long)i * G + c; if (L >= nwg) return false;
        int wgid = (int)L; { const int q = nwg / NXCD, r = nwg % NXCD, xcd = wgid % NXCD, off = wgid / NXCD; wgid = (xcd < r ? xcd * (q + 1) : r * (q + 1) + (xcd - r) * q) + off; }
        const int nig = WGM * nN, gid = wgid / nig, fm = gid * WGM, gsz = (nM - fm) < WGM ? (nM - fm) : WGM;
        u.pm = fm + ((wgid % nig) % gsz); u.pn = (wgid % nig) / gsz; u.ks = 0; return true;
    }
    __device__ __forceinline__ void a_ready(const Unit&) const {}
    __device__ __forceinline__ void done(const Unit&) const {}
};
struct PlainSched : TileOrder {
    const char* A; const char* B; size_t a_tile, b_tile; int a_sh; unsigned a_mul;
    __device__ __forceinline__ const char* a_base(const Unit& u) const { return A + (size_t)u.pm * a_tile + (size_t)((unsigned)(u.pn >> a_sh) * a_mul); }
    __device__ __forceinline__ const char* b_base(const Unit& u) const { return B + (size_t)u.pn * b_tile; }
};
struct FixedSched {
    int pm, pn0, n; const char* A; const char* B; size_t a_tile, b_tile; int a_sh; unsigned a_mul;
    __device__ __forceinline__ bool next(int i, Unit& u) const { if (i >= n) return false; u.pm = pm; u.pn = pn0 + i; u.ks = 0; return true; }
    __device__ __forceinline__ const char* a_base(const Unit& u) const { return A + (size_t)u.pm * a_tile + (size_t)((unsigned)(u.pn >> a_sh) * a_mul); }
    __device__ __forceinline__ const char* b_base(const Unit& u) const { return B + (size_t)u.pn * b_tile; }
    __device__ __forceinline__ void a_ready(const Unit&) const {}
    __device__ __forceinline__ void done(const Unit&) const {}
};
struct MoeSched {
    int nM, nN, nwg, G, c;
    const char* A; const char* B; size_t a_tile, b_tile, b_exp; int tb1, tb2, tb3, tb4, tb5, tb6, tb7;
    __device__ __forceinline__ void init_order(int nM_, int nN_, int G_, int c_) { nM = nM_; nN = nN_; nwg = nM * nN; G = G_; c = c_; }
    __device__ __forceinline__ int clip(int t) const { return t < nM ? t : nM; }
    __device__ __forceinline__ int expert(int pm) const { return __builtin_amdgcn_readfirstlane((pm >= tb1) + (pm >= tb2) + (pm >= tb3) + (pm >= tb4) + (pm >= tb5) + (pm >= tb6) + (pm >= tb7)); }
    __device__ __forceinline__ bool next(int i, Unit& u) const {
        const long L = (long)i * G + c; if (L >= nwg) return false;
        int wgid = (int)L; { const int q = nwg / NXCD, r = nwg % NXCD, xcd = wgid % NXCD, off = wgid / NXCD; wgid = (xcd < r ? xcd * (q + 1) : r * (q + 1) + (xcd - r) * q) + off; }
        const int b1 = clip(tb1), b2 = clip(tb2), b3 = clip(tb3), b4 = clip(tb4), b5 = clip(tb5), b6 = clip(tb6), b7 = clip(tb7);
        int lo = 0, hi = b1;
        if (wgid >= b1 * nN) { lo = b1; hi = b2; } if (wgid >= b2 * nN) { lo = b2; hi = b3; } if (wgid >= b3 * nN) { lo = b3; hi = b4; } if (wgid >= b4 * nN) { lo = b4; hi = b5; }
        if (wgid >= b5 * nN) { lo = b5; hi = b6; } if (wgid >= b6 * nN) { lo = b6; hi = b7; } if (wgid >= b7 * nN) { lo = b7; hi = nM; }
        const int local = wgid - lo * nN, gsz = hi - lo;
        u.pm = __builtin_amdgcn_readfirstlane(lo + local % gsz); u.pn = __builtin_amdgcn_readfirstlane(local / gsz); u.ks = 0; return true;
    }
    __device__ __forceinline__ const char* a_base(const Unit& u) const { return A + (size_t)u.pm * a_tile; }
    __device__ __forceinline__ const char* b_base(const Unit& u) const { return B + (size_t)expert(u.pm) * b_exp + (size_t)u.pn * b_tile; }
    __device__ __forceinline__ void a_ready(const Unit&) const {}
    __device__ __forceinline__ void done(const Unit&) const {}
};
struct MoeTailSched {
    int pm0, nsub, G, c; const char* A; const char* B; size_t a_tile, b_tile, b_exp, kslice, bslice; int tb1, tb2, tb3, tb4, tb5, tb6, tb7;
    __device__ __forceinline__ bool next(int i, Unit& u) const { const int j = i * G + c; if (j >= nsub) return false; const int un = j >> 2; u.ks = j & 3; u.pm = pm0 + (un >> 3); u.pn = un & 7; return true; }
    __device__ __forceinline__ int expert(int pm) const { return __builtin_amdgcn_readfirstlane((pm >= tb1) + (pm >= tb2) + (pm >= tb3) + (pm >= tb4) + (pm >= tb5) + (pm >= tb6) + (pm >= tb7)); }
    __device__ __forceinline__ const char* a_base(const Unit& u) const { return A + (size_t)u.pm * a_tile + (size_t)u.ks * kslice; }
    __device__ __forceinline__ const char* b_base(const Unit& u) const { return B + (size_t)expert(u.pm) * b_exp + (size_t)u.pn * b_tile + (size_t)u.ks * bslice; }
    __device__ __forceinline__ void a_ready(const Unit&) const {}
    __device__ __forceinline__ void done(const Unit&) const {}
};

struct EpiF32 {
    static constexpr bool PERM = false;
    float* C; int ldc;
    __device__ __forceinline__ void operator()(const f32x4 (&acc)[2][2][4][2], const Unit& u, int wr, int wc, int fr, int fq) const {
        const int row0 = u.pm * BM + wr * 64 + fr, col0 = u.pn * BM + wc * 32 + 4 * fq;
#pragma unroll
        for (int ai = 0; ai < 2; ++ai)
#pragma unroll
            for (int m = 0; m < 4; ++m) { float* rowp = C + (size_t)(row0 + ai * HALF + m * 16) * ldc + col0;
#pragma unroll
                for (int bj = 0; bj < 2; ++bj)
#pragma unroll
                    for (int n = 0; n < 2; ++n) *(f32x4*)(rowp + bj * HALF + n * 16) = acc[ai][bj][m][n]; }
    }
};
struct EpiF32Slab {
    static constexpr bool PERM = false;
    float* C; int ldc; size_t slab; int pm0;
    __device__ __forceinline__ void operator()(const f32x4 (&acc)[2][2][4][2], const Unit& u, int wr, int wc, int fr, int fq) const {
        const int row0 = (u.pm - pm0) * BM + wr * 64 + fr, col0 = u.pn * BM + wc * 32 + 4 * fq; float* base = C + (size_t)u.ks * slab;
#pragma unroll
        for (int ai = 0; ai < 2; ++ai)
#pragma unroll
            for (int m = 0; m < 4; ++m) { float* rowp = base + (size_t)(row0 + ai * HALF + m * 16) * ldc + col0;
#pragma unroll
                for (int bj = 0; bj < 2; ++bj)
#pragma unroll
                    for (int n = 0; n < 2; ++n) *(f32x4*)(rowp + bj * HALF + n * 16) = acc[ai][bj][m][n]; }
    }
};
struct EpiBf16 {
    static constexpr bool PERM = true;
    bf16* O; int ldc; size_t slab; int pm0; float scale;
    __device__ __forceinline__ void operator()(const f32x4 (&acc)[2][2][4][2], const Unit& u, int wr, int wc, int fr, int fq) const {
        const int row0 = (u.pm - pm0) * BM + wr * 64 + fr, col0 = u.pn * BM + wc * 32 + 8 * fq; bf16* base = O + (size_t)u.ks * slab;
#pragma unroll
        for (int ai = 0; ai < 2; ++ai)
#pragma unroll
            for (int m = 0; m < 4; ++m) { bf16* rowp = base + (size_t)(row0 + ai * HALF + m * 16) * ldc + col0;
#pragma unroll
                for (int bj = 0; bj < 2; ++bj) { const f32x4 v0 = acc[ai][bj][m][0] * scale, v1 = acc[ai][bj][m][1] * scale;
                    u32x4 w; w.x = cvt_pk_bf16(v0[0], v0[1]); w.y = cvt_pk_bf16(v0[2], v0[3]); w.z = cvt_pk_bf16(v1[0], v1[1]); w.w = cvt_pk_bf16(v1[2], v1[3]);
                    *(u32x4*)(rowp + bj * HALF) = w; } }
    }
};
struct EpiSwiglu {
    static constexpr bool PERM = true;
    bf16* O; int ldc;
    __device__ __forceinline__ void operator()(const f32x4 (&acc)[2][2][4][2], const Unit& u, int wr, int wc, int fr, int fq) const {
        const int row0 = u.pm * BM + wr * 64 + fr, col0 = u.pn * HALF + wc * 32 + 8 * fq;
#pragma unroll
        for (int ai = 0; ai < 2; ++ai)
#pragma unroll
            for (int m = 0; m < 4; ++m) { bf16* rowp = O + (size_t)(row0 + ai * HALF + m * 16) * ldc + col0;
                f32x4 v[2];
#pragma unroll
                for (int n = 0; n < 2; ++n) { const f32x4 g = acc[ai][0][m][n], up = acc[ai][1][m][n];
#pragma unroll
                    for (int j = 0; j < 4; ++j) v[n][j] = g[j] * up[j] * fast_sigmoid(g[j]); }
                u32x4 w; w.x = cvt_pk_bf16(v[0][0], v[0][1]); w.y = cvt_pk_bf16(v[0][2], v[0][3]); w.z = cvt_pk_bf16(v[1][0], v[1][1]); w.w = cvt_pk_bf16(v[1][2], v[1][3]);
                *(u32x4*)rowp = w; }
    }
};
struct EpiSwigluF8 {
    static constexpr bool PERM = true;
    unsigned char* O; int ldc; float inv, oscale;
    __device__ __forceinline__ void operator()(const f32x4 (&acc)[2][2][4][2], const Unit& u, int wr, int wc, int fr, int fq) const {
        const int row0 = u.pm * BM + wr * 64 + fr, col0 = u.pn * HALF + wc * 32 + 8 * fq;
#pragma unroll
        for (int ai = 0; ai < 2; ++ai)
#pragma unroll
            for (int m = 0; m < 4; ++m) { unsigned char* rowp = O + (size_t)(row0 + ai * HALF + m * 16) * ldc + col0;
                f32x4 v[2];
#pragma unroll
                for (int n = 0; n < 2; ++n) {
                    const f32x4 ex = acc[ai][0][m][n] * (-1.4426950408889634f * inv), pr = (acc[ai][0][m][n] * acc[ai][1][m][n]) * (inv * inv * oscale);
                    f32x4 t;
#pragma unroll
                    for (int j = 0; j < 4; ++j) t[j] = __builtin_amdgcn_exp2f(ex[j]);
                    t = t + 1.0f;
#pragma unroll
                    for (int j = 0; j < 4; ++j) t[j] = __builtin_amdgcn_rcpf(t[j]);
                    v[n] = pr * t; }
                u32x2 w; w.x = cvt_pk4_fp8(v[0][0], v[0][1], v[0][2], v[0][3]); w.y = cvt_pk4_fp8(v[1][0], v[1][1], v[1][2], v[1][3]);
                *(u32x2*)rowp = w; }
    }
};
struct EpiBf16I8 {
    static constexpr bool PERM = true;
    bf16* O; int ldc; const float* rs; const unsigned* amax_bits;
    __device__ __forceinline__ void operator()(const f32x4 (&acc)[2][2][4][2], const Unit& u, int wr, int wc, int fr, int fq) const {
        const int row0 = u.pm * BM + wr * 64 + fr, col0 = u.pn * BM + wc * 32 + 8 * fq;
        const float wsc = __uint_as_float(*amax_bits) * (1.0f / 127.0f);
        float rsv[8];
#pragma unroll
        for (int i = 0; i < 8; ++i) rsv[i] = rs[row0 + (i >> 2) * HALF + (i & 3) * 16];
#pragma unroll
        for (int ai = 0; ai < 2; ++ai)
#pragma unroll
            for (int m = 0; m < 4; ++m) { const int row = row0 + ai * HALF + m * 16; bf16* rowp = O + (size_t)row * ldc + col0; const float sc = rsv[ai * 4 + m] * wsc;
#pragma unroll
                for (int bj = 0; bj < 2; ++bj) { const i32x4v a0 = __builtin_bit_cast(i32x4v, acc[ai][bj][m][0]), a1 = __builtin_bit_cast(i32x4v, acc[ai][bj][m][1]);
                    u32x4 w; w.x = cvt_pk_bf16((float)a0[0] * sc, (float)a0[1] * sc); w.y = cvt_pk_bf16((float)a0[2] * sc, (float)a0[3] * sc); w.z = cvt_pk_bf16((float)a1[0] * sc, (float)a1[1] * sc); w.w = cvt_pk_bf16((float)a1[2] * sc, (float)a1[3] * sc);
                    *(u32x4*)(rowp + bj * HALF) = w; } }
    }
};
template <bool OUT_F8> struct EpiSwigluI8T {
    static constexpr bool PERM = true;
    bf16* O; int ldc; const float* rs; const unsigned* amax_bits;
    __device__ __forceinline__ void operator()(const f32x4 (&acc)[2][2][4][2], const Unit& u, int wr, int wc, int fr, int fq) const {
        const int row0 = u.pm * BM + wr * 64 + fr, col0 = u.pn * HALF + wc * 32 + 8 * fq;
        const float wsc = __uint_as_float(*amax_bits) * (1.0f / 127.0f);
        float rsv[8];
#pragma unroll
        for (int i = 0; i < 8; ++i) rsv[i] = rs[row0 + (i >> 2) * HALF + (i & 3) * 16];
#pragma unroll
        for (int ai = 0; ai < 2; ++ai)
#pragma unroll
            for (int m = 0; m < 4; ++m) { const int row = row0 + ai * HALF + m * 16; bf16* rowp = O + (size_t)row * ldc + col0; const float sc = rsv[ai * 4 + m] * wsc;
                f32x4 v[2];
#pragma unroll
                for (int n = 0; n < 2; ++n) { const i32x4v gi = __builtin_bit_cast(i32x4v, acc[ai][0][m][n]), ui = __builtin_bit_cast(i32x4v, acc[ai][1][m][n]);
                    f32x4 gf, uf;
#pragma unroll
                    for (int j = 0; j < 4; ++j) { gf[j] = (float)gi[j]; uf[j] = (float)ui[j]; }
                    const f32x4 ex = gf * (-1.4426950408889634f * sc), pr = (gf * uf) * (OUT_F8 ? sc * sc * F8_SH : sc * sc);
                    f32x4 t;
#pragma unroll
                    for (int j = 0; j < 4; ++j) t[j] = __builtin_amdgcn_exp2f(ex[j]);
                    t = t + 1.0f;
#pragma unroll
                    for (int j = 0; j < 4; ++j) t[j] = __builtin_amdgcn_rcpf(t[j]);
                    v[n] = pr * t; }
                if (OUT_F8) { u32x2 w; w.x = cvt_pk4_fp8(v[0][0], v[0][1], v[0][2], v[0][3]); w.y = cvt_pk4_fp8(v[1][0], v[1][1], v[1][2], v[1][3]);
                    *(u32x2*)((unsigned char*)O + (size_t)row * ldc + col0) = w; }
                else { u32x4 w; w.x = cvt_pk_bf16(v[0][0], v[0][1]); w.y = cvt_pk_bf16(v[0][2], v[0][3]); w.z = cvt_pk_bf16(v[1][0], v[1][1]); w.w = cvt_pk_bf16(v[1][2], v[1][3]);
                    *(u32x4*)rowp = w; } }
    }
};
typedef EpiSwigluI8T<false> EpiSwigluI8; typedef EpiSwigluI8T<true> EpiSwigluI8F8;
struct EpiGates {
    static constexpr bool PERM = false;
    const float* ba; const float* bx; const float* sp  ; const bf16* xc; unsigned* AU;
    __device__ __forceinline__ void operator()(const f32x4 (&acc)[2][2][4][2], const Unit& u, int wr, int wc, int fr, int fq) const {
        const int row0 = u.pm * BM + wr * 64 + fr, ch0 = u.pn * HALF + wc * 32 + 4 * fq;
        f32x4 bav[2], bxv[2], spv[2];
#pragma unroll
        for (int n = 0; n < 2; ++n) { bav[n] = *(const f32x4*)(ba + ch0 + n * 16); bxv[n] = *(const f32x4*)(bx + ch0 + n * 16); spv[n] = *(const f32x4*)(sp + ch0 + n * 16); }
        u32x2 xwv[8][2];
#pragma unroll
        for (int i = 0; i < 8; ++i)
#pragma unroll
            for (int n = 0; n < 2; ++n) xwv[i][n] = *(const u32x2*)(xc + (size_t)(row0 + (i >> 2) * HALF + (i & 3) * 16) * DLRU + ch0 + n * 16);
        asm volatile("" ::: "memory");
#pragma unroll
        for (int ai = 0; ai < 2; ++ai)
#pragma unroll
            for (int m = 0; m < 4; ++m) { const size_t ro = (size_t)(row0 + ai * HALF + m * 16) * DLRU + ch0;
#pragma unroll
                for (int n = 0; n < 2; ++n) {
                    const f32x4 xa = acc[ai][0][m][n] + bav[n], xx = acc[ai][1][m][n] + bxv[n];
                    const u32x2 xw = xwv[ai * 4 + m][n]; const f32x4 xv = bf4(xw);
                    f32x4 ea = xa * -1.4426950408889634f;
#pragma unroll
                    for (int j = 0; j < 4; ++j) ea[j] = __builtin_amdgcn_exp2f(ea[j]);
                    ea = ea + 1.0f;
#pragma unroll
                    for (int j = 0; j < 4; ++j) ea[j] = __builtin_amdgcn_rcpf(ea[j]);
                    const f32x4 la = spv[n] * ea;
                    f32x4 a = la * 1.4426950408889634f;
#pragma unroll
                    for (int j = 0; j < 4; ++j) a[j] = __builtin_amdgcn_exp2f(a[j]);
                    f32x4 om = 1.0f - a * a;
#pragma unroll
                    for (int j = 0; j < 4; ++j) om[j] = fmaxf(om[j], 1.0e-30f);
                    f32x4 t = xx * -1.4426950408889634f;
#pragma unroll
                    for (int j = 0; j < 4; ++j) t[j] = __builtin_amdgcn_exp2f(t[j]);
                    t = t + 1.0f;
                    f32x4 r = om * t * t;
#pragma unroll
                    for (int j = 0; j < 4; ++j) r[j] = __builtin_amdgcn_rsqf(r[j]);
                    const f32x4 uu = xv * om * r;
                    u32x4 w;
#pragma unroll
                    for (int j = 0; j < 4; ++j) w[j] = cvt_pk_bf16(la[j], uu[j]);
                    *(u32x4*)(AU + ro + n * 16) = w; }
                asm volatile("" ::: "memory"); }
    }
};
template <bool XIN_BF> struct EpiLnFusedT {
    static constexpr bool PERM = true;
    static constexpr float oscale = XIN_BF ? 1.0f / (F8_SH * F8_SB2) : 1.0f;
    const float* xin; bf16* xout; unsigned char* hout; float* rs;
    const float* gate; const float* lng; const float* lnb; const float* shift; const float* scale;
    unsigned long long* xb1; unsigned* xb2; unsigned* cnt1; unsigned* cnt2; PG8_LAS unsigned char* lds;
    __device__ __forceinline__ bool wait_cnt(unsigned* c) const {
        bool ok = false;
        for (int it = 0; it < 400000; ++it) { if ((unsigned)__builtin_amdgcn_readfirstlane(__hip_atomic_load(c, __ATOMIC_RELAXED, __HIP_MEMORY_SCOPE_AGENT)) >= 32u) { ok = true; break; } __builtin_amdgcn_s_sleep(2); }
        return ok;
    }
    __device__ __forceinline__ void operator()(f32x4 (&acc)[2][2][4][2], const Unit& u, int wr, int wc, int fr, int fq) const {
        constexpr int DD = 2048;
        const int wid = wr * 4 + wc, lane = fr + 16 * fq, tid = wid * 64 + lane;
        PG8_LAS f32x2* P = (PG8_LAS f32x2*)(lds + 131072 + 1024);
        PG8_LAS f32x2* S = P + 1024;
        const int b = u.pm >> 3, col0 = u.pn * 256 + wc * 32 + 8 * fq, row0 = u.pm * 256 + wr * 64 + fr;
        { f32x4 gv[2][2];
#pragma unroll
          for (int bj = 0; bj < 2; ++bj)
#pragma unroll
              for (int n = 0; n < 2; ++n) gv[bj][n] = (*(const f32x4*)(gate + (size_t)b * 3 * DD + col0 + bj * 128 + 4 * n) + 1.0f) * oscale;
#pragma unroll
          for (int ai = 0; ai < 2; ++ai)
#pragma unroll
              for (int m = 0; m < 4; ++m) { const size_t xoff = (size_t)(row0 + ai * 128 + m * 16) * DD + col0;
                  f32x4 xv[2][2];
                  if (XIN_BF) {
#pragma unroll
                      for (int bj = 0; bj < 2; ++bj) { const u32x4 w = *(const u32x4*)((const bf16*)xin + xoff + bj * 128); xv[bj][0] = (f32x4){bf_lo(w.x), bf_hi(w.x), bf_lo(w.y), bf_hi(w.y)}; xv[bj][1] = (f32x4){bf_lo(w.z), bf_hi(w.z), bf_lo(w.w), bf_hi(w.w)}; }
                  } else {
#pragma unroll
                      for (int bj = 0; bj < 2; ++bj)
#pragma unroll
                          for (int n = 0; n < 2; ++n) xv[bj][n] = *(const f32x4*)((const float*)xin + xoff + bj * 128 + 4 * n); }
                  float sm = 0.f, sq = 0.f;
#pragma unroll
                  for (int bj = 0; bj < 2; ++bj)
#pragma unroll
                      for (int n = 0; n < 2; ++n) { const f32x4 y = DN_ALPHA * xv[bj][n] + gv[bj][n] * acc[ai][bj][m][n]; acc[ai][bj][m][n] = y;
                          sm += (y[0] + y[1]) + (y[2] + y[3]); sq += (y[0] * y[0] + y[1] * y[1]) + (y[2] * y[2] + y[3] * y[3]); }
                  sm += __shfl_xor(sm, 16); sm += __shfl_xor(sm, 32); sq += __shfl_xor(sq, 16); sq += __shfl_xor(sq, 32);
                  if (fq == 0) P[(ai * 128 + wr * 64 + m * 16 + fr) * 4 + wc] = (f32x2){sm, sq}; } }
        __syncthreads();
        if (tid < 256) { const f32x2 a = P[tid * 4 + 0], b2 = P[tid * 4 + 1], c = P[tid * 4 + 2], d = P[tid * 4 + 3];
            const float sm = (a.x + b2.x) + (c.x + d.x), sq = (a.y + b2.y) + (c.y + d.y);
            __hip_atomic_store(xb1 + ((size_t)(u.pm * 256 + tid) * 8 + u.pn), ((unsigned long long)__float_as_uint(sq) << 32) | __float_as_uint(sm), __ATOMIC_RELAXED, __HIP_MEMORY_SCOPE_AGENT);
            asm volatile("s_waitcnt vmcnt(0)" ::: "memory");
            if (lane == 0) __hip_atomic_fetch_add(cnt1 + 64 * u.pm, 1u, __ATOMIC_RELAXED, __HIP_MEMORY_SCOPE_AGENT); }
        if (wid == 0) (void)wait_cnt(cnt1 + 64 * u.pm);
        __syncthreads();
        if (tid < 256) { float sm = 0.f, sq = 0.f;
#pragma unroll
            for (int t = 0; t < 8; ++t) { const unsigned long long w = __hip_atomic_load(xb1 + ((size_t)(u.pm * 256 + tid) * 8 + t), __ATOMIC_RELAXED, __HIP_MEMORY_SCOPE_AGENT); sm += __uint_as_float((unsigned)w); sq += __uint_as_float((unsigned)(w >> 32)); }
            const float mean = sm * (1.0f / DD), var = fmaxf(sq * (1.0f / DD) - mean * mean, 0.f);
            S[tid] = (f32x2){mean, 1.0f / sqrtf(var + LN_EPS)}; }
        __syncthreads();
        { float mxr[8];
#pragma unroll
          for (int i = 0; i < 8; ++i) mxr[i] = 0.f;
#pragma unroll
          for (int bj = 0; bj < 2; ++bj) { f32x4 gl[2], bl[2], sc[2], sh[2];
#pragma unroll
              for (int n = 0; n < 2; ++n) { const int c = col0 + bj * 128 + 4 * n; gl[n] = *(const f32x4*)(lng + c); bl[n] = *(const f32x4*)(lnb + c);
                  sc[n] = *(const f32x4*)(scale + (size_t)b * 3 * DD + c) + 1.0f; sh[n] = *(const f32x4*)(shift + (size_t)b * 3 * DD + c); }
#pragma unroll
              for (int ai = 0; ai < 2; ++ai)
#pragma unroll
                  for (int m = 0; m < 4; ++m) { const int rl = ai * 128 + wr * 64 + m * 16 + fr; const f32x2 sr = S[rl]; f32x4 xn[2]; float mx = mxr[ai * 4 + m];
#pragma unroll
                      for (int n = 0; n < 2; ++n) { xn[n] = (acc[ai][bj][m][n] - sr.x) * sr.y * gl[n] + bl[n]; const f32x4 hf = xn[n] * sc[n] + sh[n]; acc[ai][bj][m][n] = hf;
                          mx = fmaxf(mx, fmaxf(fmaxf(fabsf(hf[0]), fabsf(hf[1])), fmaxf(fabsf(hf[2]), fabsf(hf[3])))); }
                      mxr[ai * 4 + m] = mx;
                      u32x4 w; w.x = cvt_pk_bf16(xn[0][0], xn[0][1]); w.y = cvt_pk_bf16(xn[0][2], xn[0][3]); w.z = cvt_pk_bf16(xn[1][0], xn[1][1]); w.w = cvt_pk_bf16(xn[1][2], xn[1][3]);
                      *(u32x4*)(xout + (size_t)(u.pm * 256 + rl) * DD + col0 + bj * 128) = w; }
              asm volatile("" ::: "memory"); }
#pragma unroll
          for (int ai = 0; ai < 2; ++ai)
#pragma unroll
              for (int m = 0; m < 4; ++m) { float mx = mxr[ai * 4 + m]; mx = fmaxf(mx, __shfl_xor(mx, 16)); mx = fmaxf(mx, __shfl_xor(mx, 32));
                  if (fq == 0) P[(ai * 128 + wr * 64 + m * 16 + fr) * 4 + wc] = (f32x2){mx, 0.f}; } }
        __syncthreads();
        if (tid < 256) { const float mx = fmaxf(fmaxf(P[tid * 4 + 0].x, P[tid * 4 + 1].x), fmaxf(P[tid * 4 + 2].x, P[tid * 4 + 3].x));
            __hip_atomic_store(xb2 + ((size_t)(u.pm * 256 + tid) * 8 + u.pn), __float_as_uint(mx), __ATOMIC_RELAXED, __HIP_MEMORY_SCOPE_AGENT);
            asm volatile("s_waitcnt vmcnt(0)" ::: "memory");
            if (lane == 0) __hip_atomic_fetch_add(cnt2 + 64 * u.pm, 1u, __ATOMIC_RELAXED, __HIP_MEMORY_SCOPE_AGENT); }
        if (wid == 0) (void)wait_cnt(cnt2 + 64 * u.pm);
        __syncthreads();
        if (tid < 256) { float amax = 0.f;
#pragma unroll
            for (int t = 0; t < 8; ++t) amax = fmaxf(amax, __uint_as_float(__hip_atomic_load(xb2 + ((size_t)(u.pm * 256 + tid) * 8 + t), __ATOMIC_RELAXED, __HIP_MEMORY_SCOPE_AGENT)));
            amax = fmaxf(amax, 1e-20f); S[tid] = (f32x2){127.0f / amax, 0.f};
            if (u.pn == 0) rs[u.pm * 256 + tid] = amax * (1.0f / 127.0f); }
        __syncthreads();
#pragma unroll
        for (int ai = 0; ai < 2; ++ai)
#pragma unroll
            for (int m = 0; m < 4; ++m) { const int rl = ai * 128 + wr * 64 + m * 16 + fr; const float q = S[rl].x; unsigned char* ho = hout + (size_t)(u.pm * 256 + rl) * DD + col0;
#pragma unroll
                for (int bj = 0; bj < 2; ++bj) { const f32x4 h0 = acc[ai][bj][m][0] * q, h1 = acc[ai][bj][m][1] * q;
                    u32x2 w; w.x = cvt_pk4_i8(h0[0], h0[1], h0[2], h0[3]); w.y = cvt_pk4_i8(h1[0], h1[1], h1[2], h1[3]); *(u32x2*)(ho + bj * 128) = w; } }
    }
};
typedef EpiLnFusedT<false> EpiLnFused; typedef EpiLnFusedT<true> EpiLnFusedB;
struct EpiPool {
    static constexpr bool PERM = true;
    bf16* O; int ldc; int ocol0; const float* bias; const float* scale;
    __device__ __forceinline__ void operator()(const f32x4 (&acc)[2][2][4][2], const Unit& u, int wr, int wc, int fr, int fq) const {
        const int row0 = u.pm * BM + wr * 64 + fr, pc0 = u.pn * BM + wc * 32 + 8 * fq;
        f32x4 bv[2][2], sv[2][2];
#pragma unroll
        for (int bj = 0; bj < 2; ++bj) { bv[bj][0] = *(const f32x4*)(bias + pc0 + bj * HALF); bv[bj][1] = *(const f32x4*)(bias + pc0 + bj * HALF + 4); sv[bj][0] = *(const f32x4*)(scale + pc0 + bj * HALF); sv[bj][1] = *(const f32x4*)(scale + pc0 + bj * HALF + 4); }
#pragma unroll
        for (int ai = 0; ai < 2; ++ai)
#pragma unroll
            for (int m = 0; m < 4; ++m) { bf16* rowp = O + (size_t)(row0 + ai * HALF + m * 16) * ldc + ocol0 + pc0;
#pragma unroll
                for (int bj = 0; bj < 2; ++bj) {
                    const f32x4 v0 = (acc[ai][bj][m][0] + bv[bj][0]) * sv[bj][0], v1 = (acc[ai][bj][m][1] + bv[bj][1]) * sv[bj][1];
                    u32x4 w; w.x = cvt_pk_bf16(v0[0], v0[1]); w.y = cvt_pk_bf16(v0[2], v0[3]); w.z = cvt_pk_bf16(v1[0], v1[1]); w.w = cvt_pk_bf16(v1[2], v1[3]);
                    *(u32x4*)(rowp + bj * HALF) = w; } }
    }
};

__device__ __forceinline__ const char* uniform_ptr(const char* p) {
    const unsigned long long v = (unsigned long long)p; const unsigned lo = __builtin_amdgcn_readfirstlane((unsigned)v), hi = __builtin_amdgcn_readfirstlane((unsigned)(v >> 32));
    return (const char*)(((unsigned long long)hi << 32) | lo); }
template <class Epi, class Sched, int DT = 0, bool ALIGN_EPI = true>
__device__ __forceinline__ void gemm_phase(PG8_LAS unsigned char* lds, const Gemm g, const Sched& S, const Epi& E, int wave_in) {
    int wid = wave_in; asm volatile("" : "+s"(wid));
    const int lane = lane_id_fresh();
    const int tid = wid * 64 + lane, wr = wid >> 2, wc = wid & 3, fr = lane & 15, fq = lane >> 4;
    constexpr bool FP8 = (DT == 1);
    constexpr bool BT = (DT != 0);
    const int K = g.K, nt = K / BK;
    unsigned voffA[2], voffB[2];
#pragma unroll
    for (int i = 0; i < 2; ++i) { int R, C; stage_rc(tid * 16 + i * 8192, R, C); const int Rb = Epi::PERM ? ((R & ~31) + perm32(R & 31)) : R;
        voffA[i] = (unsigned)(R * g.lda + C) * 2u; voffB[i] = BT ? (unsigned)(tid * 16 + i * 8192) : (unsigned)(Rb * g.ldb + C) * 2u; }
    const size_t kstep = (size_t)(BK * 2), kstepB = BT ? (size_t)(2 * HTB) : kstep;
    const size_t hstepA = (size_t)HALF * g.lda * 2, hstepB = BT ? (size_t)HTB : (size_t)HALF * g.ldb * 2;
    const unsigned ldsw = (unsigned)wid * 1024u;
    const unsigned ldsb = (unsigned)(size_t)lds + ldsw;
    const int aoff = lds_byte(wr * 64 + fr, fq * 8), boff = lds_byte(wc * 32 + fr, fq * 8);
#define PG8_SA(b, h) (((b) * 2 + (h)) * HTB)
#define PG8_SB(b, h) ((4 + (b) * 2 + (h)) * HTB)
#define PG8_STAGE(bufoff, gbase, voff) do { const char* _gb = uniform_ptr((const char*)(gbase)); _Pragma("unroll") for (int _i = 0; _i < 2; ++_i) { \
        unsigned _keep; asm volatile("s_nop 4\n\ts_mov_b32 %0, m0\n\ts_mov_b32 m0, %3\n\ts_nop 0\n\tglobal_load_lds_dwordx4 %1, %2\n\ts_mov_b32 m0, %0" : "=&s"(_keep) : "v"((voff)[_i]), "s"(_gb), "s"(ldsb + (unsigned)((bufoff) + _i * 8192)) : "memory"); } } while (0)
#define PG8_LDA(dst, b, h) do { if constexpr (FP8) { _Pragma("unroll") for (int m = 0; m < 4; ++m) dst##8[m] = __builtin_shufflevector(*(const PG8_LAS i32x4v*)(lds + PG8_SA(b, h) + aoff + m * 2048), *(const PG8_LAS i32x4v*)(lds + PG8_SA(b, h) + aoff + m * 2048 + 1024), 0, 1, 2, 3, 4, 5, 6, 7); } \
        else { _Pragma("unroll") for (int m = 0; m < 4; ++m) _Pragma("unroll") for (int k = 0; k < 2; ++k) dst[m][k] = *(const PG8_LAS bf16x8*)(lds + PG8_SA(b, h) + aoff + m * 2048 + k * 1024); } } while (0)
#define PG8_LDB(dst, b, h) do { if constexpr (FP8) { _Pragma("unroll") for (int n = 0; n < 2; ++n) dst##8[n] = __builtin_shufflevector(*(const PG8_LAS i32x4v*)(lds + PG8_SB(b, h) + boff + n * 2048), *(const PG8_LAS i32x4v*)(lds + PG8_SB(b, h) + boff + n * 2048 + 1024), 0, 1, 2, 3, 4, 5, 6, 7); } \
        else { _Pragma("unroll") for (int n = 0; n < 2; ++n) _Pragma("unroll") for (int k = 0; k < 2; ++k) dst[n][k] = *(const PG8_LAS bf16x8*)(lds + PG8_SB(b, h) + boff + n * 2048 + k * 1024); } } while (0)
#define PG8_CAT(x0, x1) __builtin_shufflevector(__builtin_bit_cast(i32x4v, x0), __builtin_bit_cast(i32x4v, x1), 0, 1, 2, 3, 4, 5, 6, 7)
#define PG8_MMA(ai, bj, At, Bt) do { __builtin_amdgcn_s_setprio(1); \
        if constexpr (FP8) { _Pragma("unroll") for (int m = 0; m < 4; ++m) _Pragma("unroll") for (int n = 0; n < 2; ++n) \
            acc[ai][bj][m][n] = __builtin_amdgcn_mfma_scale_f32_16x16x128_f8f6f4(Bt##8[n], At##8[m], acc[ai][bj][m][n], 0, 0, 0, 0x7F7F7F7F, 0, 0x7F7F7F7F); } \
        else if constexpr (DT == 2) { _Pragma("unroll") for (int m = 0; m < 4; ++m) _Pragma("unroll") for (int n = 0; n < 2; ++n) _Pragma("unroll") for (int k = 0; k < 2; ++k) \
            acc[ai][bj][m][n] = __builtin_bit_cast(f32x4, __builtin_amdgcn_mfma_i32_16x16x64_i8(__builtin_bit_cast(i32x4v, Bt[n][k]), __builtin_bit_cast(i32x4v, At[m][k]), __builtin_bit_cast(i32x4v, acc[ai][bj][m][n]), 0, 0, 0)); } \
        else { _Pragma("unroll") for (int m = 0; m < 4; ++m) _Pragma("unroll") for (int n = 0; n < 2; ++n) _Pragma("unroll") for (int k = 0; k < 2; ++k) \
            acc[ai][bj][m][n] = __builtin_amdgcn_mfma_f32_16x16x32_bf16(Bt[n][k], At[m][k], acc[ai][bj][m][n], 0, 0, 0); } \
        __builtin_amdgcn_s_setprio(0); } while (0)
#define PG8_WAIT_V(n) asm volatile("s_waitcnt vmcnt(" #n ")" ::: "memory")
#define PG8_WAIT_L(n) asm volatile("s_waitcnt lgkmcnt(" #n ")" ::: "memory")
#define PG8_BAR __builtin_amdgcn_s_barrier()
#define PG8_SCHED __builtin_amdgcn_sched_barrier(0)
    Unit cur, nxt; int ui = 0;
    if (!S.next(0, cur)) return;
    f32x4 acc[2][2][4][2];
#pragma unroll
    for (int a = 0; a < 2; ++a)
#pragma unroll
        for (int b = 0; b < 2; ++b)
#pragma unroll
            for (int m = 0; m < 4; ++m)
#pragma unroll
                for (int n = 0; n < 2; ++n) acc[a][b][m][n] = (f32x4){0.f, 0.f, 0.f, 0.f};
    bf16x8 At[4][2], B0[2][2], B1[2][2]; i32x8v At8[4], B08[2], B18[2];
    (void)At; (void)B0; (void)B1; (void)At8; (void)B08; (void)B18;
    const char* cA = S.a_base(cur); const char* cB = S.b_base(cur);
    S.a_ready(cur);
    PG8_STAGE(PG8_SB(0, 0), cB, voffB); PG8_STAGE(PG8_SB(0, 1), cB + hstepB, voffB); PG8_STAGE(PG8_SA(0, 0), cA, voffA); PG8_STAGE(PG8_SA(0, 1), cA + hstepA, voffA);
    if (wr == 1) PG8_BAR;
    PG8_WAIT_V(2); PG8_BAR;
    PG8_STAGE(PG8_SB(1, 0), cB + kstepB, voffB); PG8_STAGE(PG8_SA(1, 0), cA + kstep, voffA); PG8_STAGE(PG8_SB(1, 1), cB + hstepB + kstepB, voffB);
    PG8_WAIT_V(6); PG8_BAR;
    for (;;) {
        const bool has_next = S.next(ui + 1, nxt);
        const char* nA = has_next ? S.a_base(nxt) : cA; const char* nB = has_next ? S.b_base(nxt) : cB;
        for (int t = 0; t < nt; t += 2) {
            const bool last = (t == nt - 2);
            const char* a1 = cA + (size_t)(t + 1) * kstep;
            const char* a2 = last ? nA : cA + (size_t)(t + 2) * kstep; const char* b2 = last ? nB : cB + (size_t)(t + 2) * kstepB;
            const char* a3 = a2 + kstep; const char* b3 = b2 + kstepB;
            if (last && has_next) S.a_ready(nxt);
            PG8_LDB(B0, 0, 0); PG8_LDB(B1, 0, 1); PG8_SCHED; PG8_LDA(At, 0, 0); PG8_STAGE(PG8_SA(1, 1), a1 + hstepA, voffA);
            PG8_WAIT_V(8); PG8_WAIT_L(0); PG8_BAR; PG8_MMA(0, 0, At, B0); PG8_MMA(0, 1, At, B1); PG8_BAR; PG8_SCHED;
            PG8_LDA(At, 0, 1); PG8_STAGE(PG8_SB(0, 0), b2, voffB); PG8_STAGE(PG8_SB(0, 1), b2 + hstepB, voffB); PG8_STAGE(PG8_SA(0, 0), a2, voffA);
            PG8_WAIT_V(8); PG8_WAIT_L(0); PG8_BAR; PG8_MMA(1, 0, At, B0); PG8_MMA(1, 1, At, B1); PG8_BAR; PG8_SCHED;
            PG8_LDB(B0, 1, 0); PG8_LDB(B1, 1, 1); PG8_SCHED; PG8_LDA(At, 1, 0); PG8_STAGE(PG8_SA(0, 1), a2 + hstepA, voffA);
            PG8_WAIT_V(8); PG8_WAIT_L(0); PG8_BAR; PG8_MMA(0, 0, At, B0); PG8_MMA(0, 1, At, B1); PG8_BAR; PG8_SCHED;
            PG8_LDA(At, 1, 1); PG8_STAGE(PG8_SB(1, 0), b3, voffB); PG8_STAGE(PG8_SB(1, 1), b3 + hstepB, voffB); PG8_STAGE(PG8_SA(1, 0), a3, voffA);
            PG8_WAIT_V(8); PG8_WAIT_L(0); PG8_BAR; PG8_MMA(1, 0, At, B0); PG8_MMA(1, 1, At, B1); PG8_BAR; PG8_SCHED;
        }
        if constexpr (ALIGN_EPI) { if (wr == 0) PG8_BAR; }
        { const int l2 = lane_id_fresh(); E(acc, cur, wr, wc, l2 & 15, l2 >> 4); } S.done(cur);
        if (!has_next) break;
#pragma unroll
        for (int a = 0; a < 2; ++a)
#pragma unroll
            for (int b = 0; b < 2; ++b)
#pragma unroll
                for (int m = 0; m < 4; ++m)
#pragma unroll
                    for (int n = 0; n < 2; ++n) acc[a][b][m][n] = (f32x4){0.f, 0.f, 0.f, 0.f};
        cur = nxt; cA = nA; cB = nB; ++ui;
        if constexpr (ALIGN_EPI) { if (wr == 1) PG8_BAR; }
    }
    PG8_WAIT_V(0);
    if constexpr (!ALIGN_EPI) { if (wr == 0) PG8_BAR; }
    PG8_BAR;
#undef PG8_SA
#undef PG8_SB
#undef PG8_STAGE
#undef PG8_LDA
#undef PG8_LDB
#undef PG8_MMA
#undef PG8_CAT
#undef PG8_WAIT_V
#undef PG8_WAIT_L
#undef PG8_BAR
#undef PG8_SCHED
}
}

constexpr size_t MiB = 1u << 20;
constexpr size_t WS_CTL = 0, CTL_ZERO_BYTES = 64 * 1024;
constexpr size_t WS_MOD = 1 * MiB;
constexpr size_t WS_SP = 1 * MiB + 512 * 1024;
constexpr size_t WS_META = 2 * MiB;
constexpr size_t META_TOKE = 0, META_TOKP = 64 * 1024, META_POS = 192 * 1024, META_INTS = 320 * 1024;
constexpr size_t WS_WIN = 4 * MiB;
constexpr size_t WS_WOUT = WS_WIN + 24 * MiB;
constexpr size_t WS_WG = WS_WOUT + 16 * MiB;
constexpr size_t WS_WP = WS_WG + 2 * MiB;
constexpr size_t WS_WGU = WS_WP + 1 * MiB;
constexpr size_t WS_WD = WS_WGU + 44 * MiB;
constexpr size_t WS_WEGU = WS_WD + 22 * MiB;
constexpr size_t WS_WED = WS_WEGU + 448 * MiB;
constexpr size_t WS_X = WS_WED + 224 * MiB;
constexpr size_t WS_H = WS_X + 64 * MiB;
constexpr size_t WS_O = WS_H + 32 * MiB;
constexpr size_t WS_R = WS_O + 64 * MiB;
constexpr size_t WS_Z = WS_R;
constexpr size_t WS_XC = WS_Z + 48 * MiB;
constexpr size_t WS_PP = WS_XC + 16 * MiB;
constexpr size_t WS_A = WS_PP + 16 * MiB;
constexpr size_t WS_U = WS_A + 32 * MiB;
constexpr size_t WS_YCAT = WS_U + 32 * MiB;
constexpr size_t WS_HID = WS_R;
constexpr size_t WS_HS = WS_R;
constexpr size_t WS_HIDS = WS_HS + 72 * MiB;
constexpr size_t WS_YBUF = WS_HIDS + 252 * MiB;
constexpr size_t WS_SLAB = WS_YBUF + 144 * MiB;
constexpr size_t SLAB_ELEMS = (size_t)2048 * 2048;
constexpr size_t WS_END = WS_SLAB + 64 * MiB;
static_assert(WS_YCAT + 32 * MiB <= WS_END && WS_HID + 88 * MiB <= WS_END, "overlay");
constexpr int CW_AMAX = 512;
constexpr size_t META_RS = 512 * 1024;
constexpr int CW_LNC = 8192;
constexpr int CW_BAR = 1024;

constexpr int RING_BYTES = 131072;
constexpr int LDSCTL_OFF = RING_BYTES;
constexpr int LDS_BYTES = 147456;

#define XB_TMO      128
#define XB_XCNT(j)  (256  + 64 * (j))
#define XB_XSUB(j)  (1280 + 64 * (j))
#define XB_XGEN(j)  (2304 + 64 * (j))
#define XB_TOP      3328
#define XB_TOPGEN   3392
#define XCD_BAR_WORDS 3456
#define XB_SPIN_CAP (1u << 18)
static_assert((CW_BAR + XCD_BAR_WORDS) * 4 <= (int)CTL_ZERO_BYTES, "barrier words inside the memset region");

__device__ __forceinline__ unsigned xb_ld(unsigned* p)              { return __hip_atomic_load(p, __ATOMIC_RELAXED, __HIP_MEMORY_SCOPE_AGENT); }
__device__ __forceinline__ unsigned xb_add(unsigned* p, unsigned v) { return __hip_atomic_fetch_add(p, v, __ATOMIC_RELAXED, __HIP_MEMORY_SCOPE_AGENT); }
__device__ __forceinline__ unsigned xb_xcc_id() { return (unsigned)__builtin_amdgcn_s_getreg((3 << 11) | 20) & 0xFu; }
#define XB_SPIN(cond, bar) do { unsigned _sp = 0; while (cond) { __builtin_amdgcn_s_sleep(1); \
    if ((++_sp & 255u) == 0u) { if (xb_ld(&(bar)[XB_TMO])) break; if (_sp > XB_SPIN_CAP) { atomicAdd(&(bar)[XB_TMO], 1u); break; } } } } while (0)

struct XcdBarrier { unsigned* bar; unsigned x; volatile LAS unsigned* st; };

__device__ __forceinline__ XcdBarrier xcd_barrier_post(unsigned* bar, volatile LAS unsigned* st) {
    XcdBarrier b; b.bar = bar; b.x = xb_xcc_id(); b.st = st;
    if (threadIdx.x == 0) (void)xb_add(&bar[XB_XCNT(b.x)], 1u);
    return b;
}
__device__ __forceinline__ bool xb_is_thread0(int wave) { return wave == 0 && lane_id_fresh() == 0; }
__device__ __forceinline__ void xcd_barrier_complete(unsigned* bar, unsigned x, unsigned& nloc, unsigned& nx) {
    const unsigned G = gridDim.x * gridDim.y * gridDim.z;
    unsigned sum, cnt, mine, sp = 0u;
    for (;;) {
        sum = 0u; cnt = 0u; mine = 0u;
#pragma unroll
        for (unsigned j = 0; j < 16; ++j) { const unsigned c = xb_ld(&bar[XB_XCNT(j)]); sum += c; cnt += (c > 0u) ? 1u : 0u; mine = (j == x) ? c : mine; }
        if (sum == G) break;
        __builtin_amdgcn_s_sleep(1);
        if ((++sp & 255u) == 0u) { if (xb_ld(&bar[XB_TMO])) break; if (sp > XB_SPIN_CAP) { atomicAdd(&bar[XB_TMO], 1u); break; } }
    }
    nloc = mine > 0u ? mine : 1u; nx = cnt > 0u ? cnt : 1u;
}
__device__ __forceinline__ void xcd_barrier(const XcdBarrier& b, int wave) {
    asm volatile("s_waitcnt vmcnt(0)" ::: "memory");
    __syncthreads();
    if (xb_is_thread0(wave)) {
        unsigned* bar = b.bar;
        __builtin_amdgcn_s_waitcnt(0);
        unsigned nloc = b.st[0], nx = b.st[1];
        if (nloc == 0u) { xcd_barrier_complete(bar, b.x, nloc, nx); b.st[0] = nloc; b.st[1] = nx; }
        const unsigned old = xb_add(&bar[XB_XSUB(b.x)], 1u);
        const unsigned gen = old / nloc;
        if (old + 1u == (gen + 1u) * nloc) {
            __builtin_amdgcn_fence(__ATOMIC_RELEASE, "agent");
            asm volatile("s_waitcnt vmcnt(0)" ::: "memory");
            const unsigned og = xb_add(&bar[XB_TOP], 1u);
            const unsigned tg = og / nx;
            if (og + 1u == (tg + 1u) * nx) xb_add(&bar[XB_TOPGEN], 1u);
            else XB_SPIN(xb_ld(&bar[XB_TOPGEN]) == tg, bar);
            __builtin_amdgcn_fence(__ATOMIC_ACQUIRE, "agent");
            xb_add(&bar[XB_XGEN(b.x)], 1u);
            asm volatile("s_waitcnt vmcnt(0)" ::: "memory");
        } else {
            XB_SPIN(xb_ld(&bar[XB_XGEN(b.x)]) == gen, bar);
            __builtin_amdgcn_fence(__ATOMIC_ACQUIRE, "agent");
            asm volatile("s_waitcnt vmcnt(0)" ::: "memory");
        }
    }
    __syncthreads();
}

#define LDS_WAIT() asm volatile("s_waitcnt lgkmcnt(0)" ::: "memory")
__device__ __forceinline__ float wave_sum(float v) {
#pragma unroll
    for (int o = 1; o < 64; o <<= 1) v += __shfl_xor(v, o);
    return v;
}

struct TItem { const float* src; unsigned char* dst; int N, ldb, f8; float scale; };
__device__ __forceinline__ void titem_load(const TItem& t, f32x4 (&v)[8], int lane) {
    const float* p = t.src + (size_t)(8 * (lane >> 3)) * t.N + 4 * (lane & 7);
#pragma unroll
    for (int i = 0; i < 8; ++i) v[i] = __builtin_nontemporal_load((const f32x4*)(p + (size_t)i * t.N));
}
__device__ __forceinline__ void titem_store(const TItem& t, const f32x4 (&v)[8], LAS float* scr, int lane) {
    (void)scr;
    {
        unsigned char* d = t.dst + (size_t)(4 * (lane & 7)) * t.ldb + 16 * (lane >> 3);
#pragma unroll
        for (int q = 0; q < 4; ++q) { u32x4 o; o.x = cvt_pk_bf16(v[0][q], v[1][q]); o.y = cvt_pk_bf16(v[2][q], v[3][q]); o.z = cvt_pk_bf16(v[4][q], v[5][q]); o.w = cvt_pk_bf16(v[6][q], v[7][q]);
            *(u32x4*)(d + (size_t)q * t.ldb) = o; }
    }
}

struct Args { const float* in[25]; float* out; unsigned char* ws; int ph_lo, ph_hi; };
enum { IN_X = 0, IN_C, IN_ADAW, IN_ADAB, IN_LNG, IN_LNB, IN_WIN, IN_CONVW, IN_CONVB, IN_WA, IN_BA, IN_WX, IN_BX, IN_LAM, IN_POOLW, IN_POOLB, IN_POOLS, IN_WOUT,
       IN_FG, IN_FU, IN_FD, IN_ROUTER, IN_EG, IN_EU, IN_ED };

constexpr int I_IN = 32 * 48, I_OUT = 32 * 64, I_SM = 32, I_FG = 32 * 88, I_FD = 88 * 32, I_EG = 32 * 112, I_ED = 112 * 32;
constexpr int T_OUT = 0, T_LRU = T_OUT + 2 * I_OUT, T_POOL = T_LRU + 16 * I_SM, T_FD = T_POOL + 8 * I_SM, T_IN = T_FD + I_FD, T_FG = T_IN + 2 * I_IN, T_ED = T_FG + 2 * I_FG, T_EG = T_ED + 8 * I_ED, T_END = T_EG + 16 * I_EG;

#ifndef CV_P2_WGS
#define CV_P2_WGS 128
#endif
#ifndef CV_P8_WGS
#define CV_P8_WGS 141
#endif
#ifndef CV_N_P2
#define CV_N_P2 19000
#endif
#ifndef CV_N_P8
#define CV_N_P8 53000
#endif
constexpr int CV_A0 = T_FG, CV_A1 = CV_A0 + CV_N_P2, CV_B1 = CV_A1 + CV_N_P8, CV_C1 = CV_B1 + CV_N_P2;
static_assert(CV_C1 <= T_END, "conversion chunks");
__device__ __forceinline__ bool titem_decode(const Args& args, unsigned char* ws, int it, int it_end, TItem& t) {
    if (it >= it_end) return false;
    const float* src; bf16* dst; int N, ldt, nblk, rowbase, mode, r, f8 = 0; float scale = 1.0f;
    if (it < T_LRU) { r = it - T_OUT; const int l = r / I_OUT; r -= l * I_OUT; src = args.in[IN_WOUT] + (size_t)l * D * D; N = D; nblk = D / 32; dst = (bf16*)(ws + WS_WOUT) + (size_t)l * D * D; ldt = D; rowbase = 0; mode = 0; }
    else if (it < T_POOL) { r = it - T_LRU; const int q = r / I_SM; r -= q * I_SM; const int l = q >> 3, ax = (q >> 2) & 1, h = q & 3;
        src = args.in[ax ? IN_WX : IN_WA] + (size_t)(l * 4 + h) * 65536; N = 256; nblk = 8; dst = (bf16*)(ws + WS_WG) + (size_t)l * 2048 * 256; ldt = 256; rowbase = h * 512 + ax * 128; mode = 1; }
    else if (it < T_FD) { r = it - T_POOL; const int q = r / I_SM; r -= q * I_SM; const int l = q >> 2, gq = q & 3;
        src = args.in[IN_POOLW] + (size_t)(l * 4 + gq) * 65536; N = 256; nblk = 8; dst = (bf16*)(ws + WS_WP) + (size_t)l * 1024 * 256; ldt = 256; rowbase = gq * 256; mode = 0; }
    else if (it < T_IN) { r = it - T_FD; src = args.in[IN_FD]; N = D; nblk = D / 64; dst = (bf16*)(ws + WS_WD); ldt = DFF / 128; rowbase = 0; mode = 0; f8 = 1; scale = F8_SB2; }
    else if (it < T_FG) { r = it - T_IN; const int l = r / I_IN; r -= l * I_IN; src = args.in[IN_WIN] + (size_t)l * D * DIN; N = DIN; nblk = DIN / 64; dst = (bf16*)(ws + WS_WIN + (size_t)l * DIN * D); ldt = D / 128; rowbase = 0; mode = 0; f8 = 2;
        scale = 127.0f / __uint_as_float(*((const unsigned*)(ws + WS_CTL) + CW_AMAX + 1 + l)); }
    else if (it < T_ED) { r = it - T_FG; const int gu = r / I_FG; r -= gu * I_FG; src = args.in[gu ? IN_FU : IN_FG]; N = DFF; nblk = DFF / 64; dst = (bf16*)(ws + WS_WGU); ldt = D / 128; rowbase = gu * 128; mode = 1; f8 = 2;
        scale = 127.0f / __uint_as_float(*((const unsigned*)(ws + WS_CTL) + CW_AMAX)); }
    else if (it < T_EG) { r = it - T_ED; const int e = r / I_ED; r -= e * I_ED; src = args.in[IN_ED] + (size_t)e * DFE * D; N = D; nblk = D / 64; dst = (bf16*)(ws + WS_WED + (size_t)e * D * DFE); ldt = DFE / 128; rowbase = 0; mode = 0; f8 = 1; scale = F8_SB2; }
    else { r = it - T_EG; const int q = r / I_EG; r -= q * I_EG; const int e = q >> 1, gu = q & 1;
        src = args.in[gu ? IN_EU : IN_EG] + (size_t)e * D * DFE; N = DFE; nblk = DFE / 64; dst = (bf16*)(ws + WS_WEGU + (size_t)e * 2 * DFE * D); ldt = D / 128; rowbase = gu * 128; mode = 1; f8 = 1; scale = F8_SB1; }
    const int kb = r / nblk, nb = r - kb * nblk, n0 = (f8 ? 64 : 32) * nb, k0 = 64 * kb;
    const int drow0 = mode ? rowbase + (n0 >> 7) * 256 + (n0 & 127) : rowbase + n0;
    t.src = src + (size_t)k0 * N + n0; t.N = N; t.f8 = f8; t.scale = scale;
    if (f8) { t.dst = (unsigned char*)dst + (size_t)(((drow0 >> 8) * ldt + (k0 >> 7)) * 2 + ((drow0 >> 7) & 1)) * 16384 + (2 * ((drow0 & 127) >> 4) + ((k0 >> 6) & 1)) * 1024; t.ldb = 0; }
    else { t.dst = (unsigned char*)dst + ((size_t)drow0 * ldt + k0) * 2; t.ldb = ldt * 2; }
    return true;
}
__device__ __forceinline__ void titem_load16(const TItem& t, f32x4 (&v)[16], int lane) {
    const float* p = t.src + (size_t)(16 * (lane >> 4)) * t.N + 4 * (lane & 15);
#pragma unroll
    for (int i = 0; i < 16; ++i) v[i] = __builtin_nontemporal_load((const f32x4*)(p + (size_t)i * t.N));
}
__device__ __forceinline__ void titem_store16(const TItem& t, const f32x4 (&v)[16], int lane) {
    const int g = lane >> 4, c = lane & 15, cp = c & 7, Rl = 32 * (c >> 3) + 16 * (cp & 1) + 4 * (cp >> 1), rr0 = Rl & 15;
    unsigned char* d = t.dst + (Rl >> 4) * 2048 + rr0 * 64 + ((16 * g) ^ (rr0 >= 8 ? 32 : 0)); const float sc = t.scale;
    if (t.f8 == 2) {
#pragma unroll
        for (int q = 0; q < 4; ++q) { u32x4 o; o.x = cvt_pk4_i8(v[0][q] * sc, v[1][q] * sc, v[2][q] * sc, v[3][q] * sc); o.y = cvt_pk4_i8(v[4][q] * sc, v[5][q] * sc, v[6][q] * sc, v[7][q] * sc);
            o.z = cvt_pk4_i8(v[8][q] * sc, v[9][q] * sc, v[10][q] * sc, v[11][q] * sc); o.w = cvt_pk4_i8(v[12][q] * sc, v[13][q] * sc, v[14][q] * sc, v[15][q] * sc); *(u32x4*)(d + 64 * q) = o; }
    } else {
#pragma unroll
        for (int q = 0; q < 4; ++q) { u32x4 o; o.x = cvt_pk4_fp8(v[0][q] * sc, v[1][q] * sc, v[2][q] * sc, v[3][q] * sc); o.y = cvt_pk4_fp8(v[4][q] * sc, v[5][q] * sc, v[6][q] * sc, v[7][q] * sc);
            o.z = cvt_pk4_fp8(v[8][q] * sc, v[9][q] * sc, v[10][q] * sc, v[11][q] * sc); o.w = cvt_pk4_fp8(v[12][q] * sc, v[13][q] * sc, v[14][q] * sc, v[15][q] * sc); *(u32x4*)(d + 64 * q) = o; }
    }
}
__device__ __forceinline__ void convert_items_bf16(const Args& args, unsigned char* ws, LAS unsigned char* lds, int it0, int it_end, int w, int nw, int wave, int lane) {
    LAS float* scr = (LAS float*)(lds + wave * 16384);
    TItem t0, t1, t2, t3; f32x4 v0[8], v1[8], v2[8], v3[8];
    int it = it0 + w;
    bool h0 = titem_decode(args, ws, it, it_end, t0), h1, h2, h3; if (h0) titem_load(t0, v0, lane); it += nw;
    h1 = titem_decode(args, ws, it, it_end, t1); if (h1) titem_load(t1, v1, lane); it += nw;
    h2 = titem_decode(args, ws, it, it_end, t2); if (h2) titem_load(t2, v2, lane); it += nw;
    for (;;) {
        if (!h0) break; h3 = titem_decode(args, ws, it, it_end, t3); if (h3) titem_load(t3, v3, lane); it += nw; titem_store(t0, v0, scr, lane);
        if (!h1) break; h0 = titem_decode(args, ws, it, it_end, t0); if (h0) titem_load(t0, v0, lane); it += nw; titem_store(t1, v1, scr, lane);
        if (!h2) break; h1 = titem_decode(args, ws, it, it_end, t1); if (h1) titem_load(t1, v1, lane); it += nw; titem_store(t2, v2, scr, lane);
        if (!h3) break; h2 = titem_decode(args, ws, it, it_end, t2); if (h2) titem_load(t2, v2, lane); it += nw; titem_store(t3, v3, scr, lane);
    }
}
__device__ __forceinline__ void convert_items(const Args& args, unsigned char* ws, LAS unsigned char* lds, int it0, int it_end, int w, int nw, int wave, int lane) {
    (void)lds; (void)wave;
    TItem t0, t1; f32x4 v0[16], v1[16];
    int it = it0 + w;
    bool h0 = titem_decode(args, ws, it, it_end, t0), h1; if (h0) titem_load16(t0, v0, lane); it += nw;
    for (;;) {
        if (!h0) break; h1 = titem_decode(args, ws, it, it_end, t1); if (h1) titem_load16(t1, v1, lane); it += nw; titem_store16(t0, v0, lane);
        if (!h1) break; h0 = titem_decode(args, ws, it, it_end, t0); if (h0) titem_load16(t0, v0, lane); it += nw; titem_store16(t1, v1, lane);
    }
}

__device__ __forceinline__ float absmax_span(const float* w, int n4, int gw, int NGW, int lane) {
    float mx = 0.f;
#pragma unroll 1
    for (int i0 = gw * 64 + lane; i0 < n4; i0 += NGW * 64 * 8) { f32x4 a[8];
#pragma unroll
        for (int q = 0; q < 8; ++q) { const int i = i0 + q * NGW * 64; a[q] = (i < n4) ? __builtin_nontemporal_load((const f32x4*)w + i) : (f32x4){0.f, 0.f, 0.f, 0.f}; }
#pragma unroll
        for (int q = 0; q < 8; ++q) mx = fmaxf(mx, fmaxf(fmaxf(fabsf(a[q][0]), fabsf(a[q][1])), fmaxf(fabsf(a[q][2]), fabsf(a[q][3])))); }
#pragma unroll
    for (int o = 1; o < 64; o <<= 1) mx = fmaxf(mx, __shfl_xor(mx, o));
    return mx;
}
__device__ __forceinline__ void p0_absmax(const Args& args, unsigned* amax_bits, LAS unsigned char* lds, int gw, int NGW, int tid, int lane) {
    const float m0 = fmaxf(absmax_span(args.in[IN_FG], D * DFF / 4, gw, NGW, lane), absmax_span(args.in[IN_FU], D * DFF / 4, gw, NGW, lane));
    const float m1 = absmax_span(args.in[IN_WIN], D * DIN / 4, gw, NGW, lane), m2 = absmax_span(args.in[IN_WIN] + (size_t)D * DIN, D * DIN / 4, gw, NGW, lane);
    LAS float* red = (LAS float*)lds;
    if (lane == 0) { red[(tid >> 6) * 3 + 0] = m0; red[(tid >> 6) * 3 + 1] = m1; red[(tid >> 6) * 3 + 2] = m2; }
    __syncthreads();
    if (tid < 3) { float m = red[tid];
#pragma unroll
        for (int w = 1; w < 8; ++w) m = fmaxf(m, red[w * 3 + tid]);
        (void)__hip_atomic_fetch_max(amax_bits + tid, __float_as_uint(m), __ATOMIC_RELAXED, __HIP_MEMORY_SCOPE_AGENT); }
}

__device__ __forceinline__ void p0_adaln(const Args& args, unsigned char* ws, LAS unsigned char* lds, int vcu, int G, int tid, int wave, int lane) {
    LAS float* cact = (LAS float*)lds;
    LAS float* red = (LAS float*)(lds + 32768);
    for (int i = tid; i < NB * D; i += 512) { const float v = args.in[IN_C][i]; cact[i] = v * fast_sigmoid(v); }
    __syncthreads();
    float* mod = (float*)(ws + WS_MOD);
    for (int item = vcu; item < 256; item += G) {
        const int ls = item >> 6, cb = item & 63;
        const int lc = lane < 48 ? lane : 47;
        const float* W = args.in[IN_ADAW] + (size_t)ls * D * 3 * D + cb * 96 + lc * 2;
        f32x2 acc[4];
#pragma unroll
        for (int b = 0; b < 4; ++b) acc[b] = (f32x2){0.f, 0.f};
        const int kbeg = wave * 256;
#pragma unroll 1
        for (int k0 = kbeg; k0 < kbeg + 256; k0 += 16) { f32x2 wv[16];
#pragma unroll
            for (int i = 0; i < 16; ++i) wv[i] = __builtin_nontemporal_load((const f32x2*)(W + (size_t)(k0 + i) * (3 * D)));
#pragma unroll
            for (int i = 0; i < 16; ++i) {
#pragma unroll
                for (int b = 0; b < 4; ++b) { const float cv = cact[b * D + k0 + i]; acc[b] += wv[i] * cv; } } }
        if (lane < 48) {
#pragma unroll
            for (int b = 0; b < 4; ++b) { red[(wave * 4 + b) * 96 + lane * 2] = acc[b].x; red[(wave * 4 + b) * 96 + lane * 2 + 1] = acc[b].y; } }
        __syncthreads();
        if (tid < 384) { const int b = tid / 96, cc = tid - b * 96; float s = args.in[IN_ADAB][ls * 3 * D + cb * 96 + cc];
#pragma unroll
          for (int w = 0; w < 8; ++w) s += red[(w * 4 + b) * 96 + cc];
          mod[(size_t)(ls * 4 + b) * 3 * D + cb * 96 + cc] = s; }
        __syncthreads();
    }
}

__device__ __forceinline__ void p1_mod_rows(const float* x, const float* mod_ls, bf16* h, float* rs, int gw, int NGW, int lane) {
    (void)NGW;
    const int mb = 4 * gw, b = mb / SEQ; const f32x4* sh = (const f32x4*)(mod_ls + (size_t)b * 3 * D) + lane;
    f32x4 xv[2][8], s0[8], s1[8];
#pragma unroll
    for (int j = 0; j < 8; ++j) { s0[j] = sh[64 * j]; s1[j] = sh[64 * j + D / 4] + 1.0f; xv[0][j] = ((const f32x4*)(x + (size_t)mb * D) + lane)[64 * j]; }
#pragma unroll
    for (int k = 0; k < 4; ++k) { const int m = mb + k;
        if (k + 1 < 4) {
#pragma unroll
            for (int j = 0; j < 8; ++j) xv[(k + 1) & 1][j] = ((const f32x4*)(x + (size_t)(m + 1) * D) + lane)[64 * j];
            __builtin_amdgcn_sched_barrier(0);
        }
        float amax = 0.f;
#pragma unroll
        for (int j = 0; j < 8; ++j) { const f32x4 o = xv[k & 1][j] * s1[j] + s0[j]; xv[k & 1][j] = o; amax = fmaxf(amax, fmaxf(fmaxf(fabsf(o[0]), fabsf(o[1])), fmaxf(fabsf(o[2]), fabsf(o[3])))); }
#pragma unroll
        for (int o = 1; o < 64; o <<= 1) amax = fmaxf(amax, __shfl_xor(amax, o));
        amax = fmaxf(amax, 1e-20f); const float q = 127.0f / amax;
        if (lane == 0) rs[m] = amax * (1.0f / 127.0f);
#pragma unroll
        for (int j = 0; j < 8; ++j) ((unsigned*)((unsigned char*)h + (size_t)m * D) + lane)[64 * j] = cvt_pk4_i8(xv[k & 1][j][0] * q, xv[k & 1][j][1] * q, xv[k & 1][j][2] * q, xv[k & 1][j][3] * q);
    }
}

__device__ __forceinline__ void p3_conv_pool(const bf16* Z, const float* convw, const float* convb, bf16* XC, bf16* PP, int vcu, int G, int tid) {
    const int c0 = 2 * tid;
    const f32x2 w0 = *(const f32x2*)(convw + c0), w1 = *(const f32x2*)(convw + 1024 + c0), w2 = *(const f32x2*)(convw + 2048 + c0), w3 = *(const f32x2*)(convw + 3072 + c0), cb = *(const f32x2*)(convb + c0);
    const int win = 2 << (tid >> 7);
    for (int item = vcu; item < NB * (SEQ / 32); item += G) {
        const int b = item / (SEQ / 32), t0 = (item - b * (SEQ / 32)) * 32;
        const bf16* zb = Z + (size_t)b * SEQ * DIN;
        unsigned cr[35], pr[47];
#pragma unroll
        for (int i = 0; i < 35; ++i) { const int t = t0 - 3 + i; cr[i] = *(const unsigned*)(zb + (size_t)(t < 0 ? 0 : t) * DIN + c0); }
#pragma unroll
        for (int i = 0; i < 47; ++i) { const int t = t0 - 15 + i; pr[i] = *(const unsigned*)(zb + (size_t)(t < 0 ? 0 : t) * DIN + 2048 + c0); }
        if (t0 == 0) {
#pragma unroll
            for (int i = 0; i < 3; ++i) cr[i] = 0u;
#pragma unroll
            for (int i = 0; i < 15; ++i) pr[i] = 0u;
        }
#pragma unroll
        for (int i = 0; i < 32; ++i) { const f32x2 xm3 = {bf_lo(cr[i]), bf_hi(cr[i])}, xm2 = {bf_lo(cr[i + 1]), bf_hi(cr[i + 1])}, xm1 = {bf_lo(cr[i + 2]), bf_hi(cr[i + 2])}, x0 = {bf_lo(cr[i + 3]), bf_hi(cr[i + 3])};
            const f32x2 y = cb + w0 * xm3 + w1 * xm2 + w2 * xm1 + w3 * x0;
            *(unsigned*)(XC + (size_t)(b * SEQ + t0 + i) * DLRU + c0) = cvt_pk_bf16(y.x, y.y); }
        f32x2 sacc = {0.f, 0.f};
#pragma unroll
        for (int i = 0; i < 15; ++i) { if (i >= 16 - win) sacc += (f32x2){bf_lo(pr[i]), bf_hi(pr[i])}; }
#pragma unroll
        for (int i = 0; i < 32; ++i) { const int t = t0 + i; const f32x2 xt = {bf_lo(pr[15 + i]), bf_hi(pr[15 + i])};
            sacc += xt; const float cnt = (float)((t + 1) < win ? (t + 1) : win);
            const f32x2 p = {sacc.x / cnt - xt.x, sacc.y / cnt - xt.y};
            *(unsigned*)(PP + (size_t)(b * SEQ + t) * DLRU + c0) = cvt_pk_bf16(p.x, p.y);
            const unsigned q2 = pr[15 + i - 1], q4 = pr[15 + i - 3], q8 = pr[15 + i - 7], q16 = pr[15 + i - 15];
            const unsigned q = win == 2 ? q2 : (win == 4 ? q4 : (win == 8 ? q8 : q16));
            sacc -= (f32x2){bf_lo(q), bf_hi(q)}; }
    }
}

__device__ __forceinline__ void conv_tile(const bf16* Z, const float* convw, const float* convb, bf16* XC, int pm, int h, int tid) {
    const int c0 = 256 * h + 4 * (tid & 63), b = pm >> 3, t0 = (pm & 7) * 256 + (tid >> 6) * 32;
    const f32x4 w0 = *(const f32x4*)(convw + c0), w1 = *(const f32x4*)(convw + 1024 + c0), w2 = *(const f32x4*)(convw + 2048 + c0), w3 = *(const f32x4*)(convw + 3072 + c0), cb = *(const f32x4*)(convb + c0);
    const bf16* zb = Z + (size_t)b * SEQ * DIN + c0;
    u32x2 cr[35];
    if (t0 == 0) {
#pragma unroll
        for (int i = 0; i < 3; ++i) cr[i] = (u32x2){0u, 0u};
#pragma unroll
        for (int i = 3; i < 35; ++i) cr[i] = *(const u32x2*)(zb + (size_t)(i - 3) * DIN);
    } else { const bf16* p0 = zb + (size_t)(t0 - 3) * DIN;
#pragma unroll
        for (int i = 0; i < 35; ++i) cr[i] = *(const u32x2*)(p0 + (size_t)i * DIN); }
    bf16* xo = XC + (size_t)(b * SEQ + t0) * DLRU + c0;
#pragma unroll
    for (int i = 0; i < 32; ++i) { const f32x4 y = cb + w0 * bf4(cr[i]) + w1 * bf4(cr[i + 1]) + w2 * bf4(cr[i + 2]) + w3 * bf4(cr[i + 3]);
        u32x2 o; o.x = cvt_pk_bf16(y[0], y[1]); o.y = cvt_pk_bf16(y[2], y[3]); *(u32x2*)(xo + (size_t)i * DLRU) = o; }
}
__device__ __forceinline__ void pool_tile(const bf16* Z, bf16* PP, int pm, int g, int tid) {
    const int c0 = 256 * g + 4 * (tid & 63), b = pm >> 3, t0 = (pm & 7) * 256 + (tid >> 6) * 32, win = 2 << g;
    const bf16* zb = Z + (size_t)b * SEQ * DIN + 2048 + c0;
    u32x2 pr[47];
    if (t0 == 0) {
#pragma unroll
        for (int i = 0; i < 15; ++i) pr[i] = (u32x2){0u, 0u};
#pragma unroll
        for (int i = 15; i < 47; ++i) pr[i] = *(const u32x2*)(zb + (size_t)(i - 15) * DIN);
    } else { const bf16* p0 = zb + (size_t)(t0 - 15) * DIN;
#pragma unroll
        for (int i = 0; i < 47; ++i) pr[i] = *(const u32x2*)(p0 + (size_t)i * DIN); }
    f32x4 sacc = {0.f, 0.f, 0.f, 0.f};
#pragma unroll
    for (int i = 0; i < 15; ++i) { if (i >= 16 - win) sacc += bf4(pr[i]); }
    bf16* po = PP + (size_t)(b * SEQ + t0) * DLRU + c0;
#pragma unroll
    for (int i = 0; i < 32; ++i) { const int t = t0 + i; const f32x4 xt = bf4(pr[15 + i]);
        sacc += xt; const float rc = __builtin_amdgcn_rcpf((float)((t + 1) < win ? (t + 1) : win));
        const f32x4 p = sacc * rc - xt;
        u32x2 o; o.x = cvt_pk_bf16(p[0], p[1]); o.y = cvt_pk_bf16(p[2], p[3]); *(u32x2*)(po + (size_t)i * DLRU) = o;
        const u32x2 q2 = pr[15 + i - 1], q4 = pr[15 + i - 3], q8 = pr[15 + i - 7], q16 = pr[15 + i - 15];
        const u32x2 q = win == 2 ? q2 : (win == 4 ? q4 : (win == 8 ? q8 : q16));
        sacc -= bf4(q); }
}

__device__ __forceinline__ void p5_scan(const unsigned* AU, const bf16* Z, bf16* YCAT, LAS unsigned char* lds, int vcu, int G, int tid) {
    LAS float* sP = (LAS float*)lds; LAS float* sH = sP + 512;
    const int c = tid & 15, seg = tid >> 4;
    for (int item = vcu; item < NB * (DLRU / 16); item += G) {
        const int b = item / (DLRU / 16), ch = (item - b * (DLRU / 16)) * 16 + c;
        const size_t row0 = (size_t)b * SEQ + seg * 64;
        const unsigned* ap = AU + row0 * DLRU + ch;
        float Ls = 0.f, H = 0.f;
#pragma unroll 1
        for (int i0 = 0; i0 < 64; i0 += 16) { unsigned wv[16];
#pragma unroll
            for (int i = 0; i < 16; ++i) wv[i] = ap[(size_t)(i0 + i) * DLRU];
#pragma unroll
            for (int i = 0; i < 16; ++i) { const float la = bf_lo(wv[i]); H = __expf(la) * H + bf_hi(wv[i]); Ls += la; } }
        sP[tid] = __expf(Ls); sH[tid] = H;
        __syncthreads();
        float h = 0.f;
        for (int s2 = 0; s2 < seg; ++s2) h = sP[s2 * 16 + c] * h + sH[s2 * 16 + c];
        const bf16* gp = Z + row0 * DIN + 1024 + ch; bf16* yp = YCAT + row0 * D + ch;
#pragma unroll 1
        for (int i0 = 0; i0 < 64; i0 += 8) { unsigned wv[8]; bf16 gv[8];
#pragma unroll
            for (int i = 0; i < 8; ++i) { wv[i] = ap[(size_t)(i0 + i) * DLRU]; gv[i] = gp[(size_t)(i0 + i) * DIN]; }
#pragma unroll
            for (int i = 0; i < 8; ++i) { h = __expf(bf_lo(wv[i])) * h + bf_hi(wv[i]); const float gz = __uint_as_float((unsigned)gv[i] << 16);
                yp[(size_t)(i0 + i) * D] = (bf16)(cvt_pk_bf16(h * gelu_tanh(gz), 0.f) & 0xffffu); } }
        __syncthreads();
    }
}

template <bool MOE_IN, bool HAS_NEXT, bool ROUTER, bool H_F8 = false, int RR = 4>
__device__ __forceinline__ void ln_phase(const float* __restrict__ xin, float* __restrict__ xout,     const bf16* O, const bf16* O2, const float* gate_mod  , const float* lng, const float* lnb,
                                         const float* next_mod, bf16* hout, const float* router_w, unsigned char* meta, LAS unsigned char* lds, int gw, int NGW, int tid, int lane) {
    LAS float* rw = (LAS float*)lds;
    if (ROUTER) { for (int i = tid; i < D * NE / 4; i += 512) ((LAS f32x4*)rw)[i] = ((const f32x4*)router_w)[i]; __syncthreads(); }
    constexpr size_t SL4 = SLAB_ELEMS / 4;
    constexpr int R = RR;
    for (int m0 = R * gw; m0 < M; m0 += R * NGW) {
        const int b = m0 / SEQ;
        const f32x4* gt = (const f32x4*)(gate_mod + (size_t)b * 3 * D + 2 * D) + lane;
        f32x4 y[R][8]; float sum[R];
#pragma unroll
        for (int r = 0; r < R; ++r) sum[r] = 0.f;
        const u32x2* yp1[R]; const u32x2* yp2[R]; f32x2 pr[R]; bool tl1[R], tl2[R];
        if (MOE_IN) {
#pragma unroll
            for (int r = 0; r < R; ++r) { const int p1 = ((const int*)(meta + META_POS))[2 * (m0 + r)], p2 = ((const int*)(meta + META_POS))[2 * (m0 + r) + 1]; pr[r] = ((const f32x2*)(meta + META_TOKP))[m0 + r];
                tl1[r] = p1 >= 2 * M; tl2[r] = p2 >= 2 * M;
                yp1[r] = tl1[r] ? (const u32x2*)(O2 + (size_t)(p1 - 2 * M) * D) + lane : (const u32x2*)(O + (size_t)p1 * D) + lane;
                yp2[r] = tl2[r] ? (const u32x2*)(O2 + (size_t)(p2 - 2 * M) * D) + lane : (const u32x2*)(O + (size_t)p2 * D) + lane; }
        }
#pragma unroll
        for (int jc = 0; jc < 4; ++jc) {
            f32x4 xv[R][2], ov[R][2], gv[2];
#pragma unroll
            for (int jj = 0; jj < 2; ++jj) { const int j = 2 * jc + jj; gv[jj] = gt[64 * j];
#pragma unroll
                for (int r = 0; r < R; ++r) { xv[r][jj] = ((const f32x4*)(xin + (size_t)(m0 + r) * D) + lane)[64 * j];
                    if (MOE_IN) { f32x4 a1 = bf4(yp1[r][64 * j]), a2 = bf4(yp2[r][64 * j]);
                        if (tl1[r]) a1 = (a1 + bf4(yp1[r][64 * j + SL4])) + (bf4(yp1[r][64 * j + 2 * SL4]) + bf4(yp1[r][64 * j + 3 * SL4]));
                        if (tl2[r]) a2 = (a2 + bf4(yp2[r][64 * j + SL4])) + (bf4(yp2[r][64 * j + 2 * SL4]) + bf4(yp2[r][64 * j + 3 * SL4]));
                        ov[r][jj] = pr[r].x * a1 + pr[r].y * a2; }
                    else ov[r][jj] = bf4(((const u32x2*)(O + (size_t)(m0 + r) * D) + lane)[64 * j]); } }
#pragma unroll
            for (int jj = 0; jj < 2; ++jj)
#pragma unroll
                for (int r = 0; r < R; ++r) { const f32x4 v = DN_ALPHA * xv[r][jj] + (1.0f + gv[jj]) * ov[r][jj]; y[r][2 * jc + jj] = v; sum[r] += (v[0] + v[1]) + (v[2] + v[3]); }
            if (ROUTER || MOE_IN) asm volatile("" ::: "memory");
        }
        float rstd[R];
#pragma unroll
        for (int r = 0; r < R; ++r) { const float mean = wave_sum(sum[r]) * (1.0f / D); float s2 = 0.f;
#pragma unroll
            for (int j = 0; j < 8; ++j) { y[r][j] = y[r][j] - mean; s2 += (y[r][j][0] * y[r][j][0] + y[r][j][1] * y[r][j][1]) + (y[r][j][2] * y[r][j][2] + y[r][j][3] * y[r][j][3]); }
            rstd[r] = 1.0f / sqrtf(wave_sum(s2) * (1.0f / D) + LN_EPS); }
        float lg[R][NE];
#pragma unroll
        for (int r = 0; r < R; ++r)
#pragma unroll
            for (int e = 0; e < NE; ++e) lg[r][e] = 0.f;
        const f32x4* shp = HAS_NEXT ? (const f32x4*)(next_mod + (size_t)b * 3 * D) + lane : nullptr;
#pragma unroll
        for (int j = 0; j < 8; ++j) { const f32x4 g = *((const f32x4*)lng + lane + 64 * j), bb = *((const f32x4*)lnb + lane + 64 * j);
            f32x4 s0 = {0.f, 0.f, 0.f, 0.f}, s1 = {0.f, 0.f, 0.f, 0.f}; if (HAS_NEXT) { s0 = shp[64 * j]; s1 = shp[64 * j + D / 4]; }
            f32x4 r0[4], r1[4];
            if (ROUTER) {
#pragma unroll
                for (int q = 0; q < 4; ++q) { const int k = 4 * lane + 256 * j + q; r0[q] = *(const LAS f32x4*)(rw + k * 8); r1[q] = *(const LAS f32x4*)(rw + k * 8 + 4); } }
#pragma unroll
            for (int r = 0; r < R; ++r) { const f32x4 xn = y[r][j] * rstd[r] * g + bb; ((f32x4*)(xout + (size_t)(m0 + r) * D) + lane)[64 * j] = xn;
                if (HAS_NEXT) { const f32x4 hf = xn * (1.0f + s1) + s0;
                    if (H_F8) { ((unsigned*)((unsigned char*)hout + (size_t)(m0 + r) * D) + lane)[64 * j] = cvt_pk4_fp8(hf[0] * F8_SA1, hf[1] * F8_SA1, hf[2] * F8_SA1, hf[3] * F8_SA1); }
                    else { u32x2 w; w.x = cvt_pk_bf16(hf[0], hf[1]); w.y = cvt_pk_bf16(hf[2], hf[3]); ((u32x2*)(hout + (size_t)(m0 + r) * D) + lane)[64 * j] = w; }
                    if (ROUTER) {
#pragma unroll
                        for (int q = 0; q < 4; ++q) { lg[r][0] += hf[q] * r0[q][0]; lg[r][1] += hf[q] * r0[q][1]; lg[r][2] += hf[q] * r0[q][2]; lg[r][3] += hf[q] * r0[q][3];
                            lg[r][4] += hf[q] * r1[q][0]; lg[r][5] += hf[q] * r1[q][1]; lg[r][6] += hf[q] * r1[q][2]; lg[r][7] += hf[q] * r1[q][3]; } } } }
            if (ROUTER || MOE_IN) asm volatile("" ::: "memory");
        }
        if (ROUTER) {
#pragma unroll
            for (int r = 0; r < R; ++r) {
#pragma unroll
                for (int e = 0; e < NE; ++e) lg[r][e] = wave_sum(lg[r][e]);
                int e1 = 0; float v1 = lg[r][0];
#pragma unroll
                for (int e = 1; e < NE; ++e) if (lg[r][e] > v1) { v1 = lg[r][e]; e1 = e; }
                int e2 = -1; float v2 = -3.0e38f;
#pragma unroll
                for (int e = 0; e < NE; ++e) if (e != e1 && lg[r][e] > v2) { v2 = lg[r][e]; e2 = e; }
                const float ex = __expf(v2 - v1), p1 = 1.0f / (1.0f + ex), p2 = ex / (1.0f + ex);
                if (lane == 0) { ((unsigned*)(meta + META_TOKE))[m0 + r] = (unsigned)e1 | ((unsigned)e2 << 8); ((f32x2*)(meta + META_TOKP))[m0 + r] = (f32x2){p1, p2}; } }
        }
    }
}

template <bool H_I8, bool XIN_BF, bool XOUT_BF>
__device__ __forceinline__ void ln_plain(const void* xin, void* xout, const bf16* O, const float* gate_mod, const float* lng, const float* lnb, const float* next_mod, bf16* hout, float* rs, int gw, int NGW, int lane) {
    constexpr int R = 2;
    for (int m0 = R * gw; m0 < M; m0 += R * NGW) {
        const int b = m0 / SEQ;
        const f32x4* gt = (const f32x4*)(gate_mod + (size_t)b * 3 * D + 2 * D) + lane;
        const f32x4* shp = (const f32x4*)(next_mod + (size_t)b * 3 * D) + lane;
        f32x4 y[R][8]; u32x2 ow[R][8]; f32x4 gv[8];
#pragma unroll
        for (int j = 0; j < 8; ++j) { gv[j] = gt[64 * j];
#pragma unroll
            for (int r = 0; r < R; ++r) { if (XIN_BF) y[r][j] = bf4(((const u32x2*)((const bf16*)xin + (size_t)(m0 + r) * D) + lane)[64 * j]); else y[r][j] = ((const f32x4*)((const float*)xin + (size_t)(m0 + r) * D) + lane)[64 * j];
                ow[r][j] = ((const u32x2*)(O + (size_t)(m0 + r) * D) + lane)[64 * j]; } }
        __builtin_amdgcn_sched_barrier(0);
        float sum[R];
#pragma unroll
        for (int r = 0; r < R; ++r) { sum[r] = 0.f;
#pragma unroll
            for (int j = 0; j < 8; ++j) { const f32x4 v = DN_ALPHA * y[r][j] + (1.0f + gv[j]) * bf4(ow[r][j]); y[r][j] = v; sum[r] += (v[0] + v[1]) + (v[2] + v[3]); } }
        f32x4 g[4], bb[4], s0[4], s1[4];
#pragma unroll
        for (int j = 0; j < 4; ++j) { g[j] = *((const f32x4*)lng + lane + 64 * j); bb[j] = *((const f32x4*)lnb + lane + 64 * j); s0[j] = shp[64 * j]; s1[j] = shp[64 * j + D / 4]; }
        __builtin_amdgcn_sched_barrier(0);
        float rstd[R];
#pragma unroll
        for (int r = 0; r < R; ++r) { const float mean = wave_sum(sum[r]) * (1.0f / D); float s2 = 0.f;
#pragma unroll
            for (int j = 0; j < 8; ++j) { y[r][j] = y[r][j] - mean; s2 += (y[r][j][0] * y[r][j][0] + y[r][j][1] * y[r][j][1]) + (y[r][j][2] * y[r][j][2] + y[r][j][3] * y[r][j][3]); }
            rstd[r] = 1.0f / sqrtf(wave_sum(s2) * (1.0f / D) + LN_EPS); }
#pragma unroll
        for (int hh = 0; hh < 2; ++hh) {
            f32x4 g2[4], bb2[4], s02[4], s12[4];
            if (hh == 0) {
#pragma unroll
                for (int j = 0; j < 4; ++j) { g2[j] = *((const f32x4*)lng + lane + 64 * (j + 4)); bb2[j] = *((const f32x4*)lnb + lane + 64 * (j + 4)); s02[j] = shp[64 * (j + 4)]; s12[j] = shp[64 * (j + 4) + D / 4]; }
                __builtin_amdgcn_sched_barrier(0);
            }
#pragma unroll
            for (int jj = 0; jj < 4; ++jj)
#pragma unroll
                for (int r = 0; r < R; ++r) { const int j = 4 * hh + jj; const f32x4 xn = y[r][j] * rstd[r] * g[jj] + bb[jj];
                    if (XOUT_BF) { u32x2 w; w.x = cvt_pk_bf16(xn[0], xn[1]); w.y = cvt_pk_bf16(xn[2], xn[3]); ((u32x2*)((bf16*)xout + (size_t)(m0 + r) * D) + lane)[64 * j] = w; } else ((f32x4*)((float*)xout + (size_t)(m0 + r) * D) + lane)[64 * j] = xn;
                    const f32x4 hf = xn * (1.0f + s1[jj]) + s0[jj];
                    if (H_I8) { y[r][j] = hf; }
                    else { u32x2 w; w.x = cvt_pk_bf16(hf[0], hf[1]); w.y = cvt_pk_bf16(hf[2], hf[3]); ((u32x2*)(hout + (size_t)(m0 + r) * D) + lane)[64 * j] = w; } }
            if (hh == 0) {
#pragma unroll
                for (int j = 0; j < 4; ++j) { g[j] = g2[j]; bb[j] = bb2[j]; s0[j] = s02[j]; s1[j] = s12[j]; } }
        }
        if (H_I8) {
#pragma unroll
            for (int r = 0; r < R; ++r) { float amax = 0.f;
#pragma unroll
                for (int j = 0; j < 8; ++j) amax = fmaxf(amax, fmaxf(fmaxf(fabsf(y[r][j][0]), fabsf(y[r][j][1])), fmaxf(fabsf(y[r][j][2]), fabsf(y[r][j][3]))));
#pragma unroll
                for (int o = 1; o < 64; o <<= 1) amax = fmaxf(amax, __shfl_xor(amax, o));
                amax = fmaxf(amax, 1e-20f); const float q = 127.0f / amax;
                if (lane == 0) rs[m0 + r] = amax * (1.0f / 127.0f);
#pragma unroll
                for (int j = 0; j < 8; ++j) ((unsigned*)((unsigned char*)hout + (size_t)(m0 + r) * D) + lane)[64 * j] = cvt_pk4_i8(y[r][j][0] * q, y[r][j][1] * q, y[r][j][2] * q, y[r][j][3] * q); }
        }
    }
}

template <bool MOE_IN, bool HAS_NEXT, bool ROUTER, bool XIN_BF, bool XOUT_BF>
__device__ __forceinline__ void ln_phase_row(const void* xin, void* xout, const bf16* O, const bf16* O2, const float* gate_mod  , const float* lng, const float* lnb,
                                         const float* next_mod, bf16* hout, const float* router_w, float* rs, unsigned char* meta, LAS unsigned char* lds, int gw, int NGW, int tid, int lane) {
    LAS float* rw = (LAS float*)lds;
    LAS f32x4* P = (LAS f32x4*)(lds + 65536);
    constexpr int RPW = 4;
    const int mb = gw * RPW, b = mb / SEQ;
    (void)NGW;
    if (ROUTER) { for (int i = tid; i < D * NE / 4; i += 512) ((LAS f32x4*)rw)[i] = ((const f32x4*)router_w)[i]; }
    { P[tid] = ((const f32x4*)lng)[tid]; P[512 + tid] = ((const f32x4*)lnb)[tid];
      if (HAS_NEXT) { const f32x4* sh = (const f32x4*)(next_mod + (size_t)b * 3 * D); P[1024 + tid] = sh[tid]; P[1536 + tid] = sh[tid + D / 4] + 1.0f; }
      P[2048 + tid] = ((const f32x4*)(gate_mod + (size_t)b * 3 * D + 2 * D))[tid] + 1.0f; }
    __syncthreads();
    u32x2 xw[2][8], ow[2][8]; f32x4 xf[2][8];
#define LN_XPRE(buf, row) do { _Pragma("unroll") for (int j = 0; j < 8; ++j) { \
        if (XIN_BF) xw[buf][j] = ((const u32x2*)((const bf16*)xin + (size_t)(row) * D) + lane)[64 * j]; else xf[buf][j] = ((const f32x4*)((const float*)xin + (size_t)(row) * D) + lane)[64 * j]; \
        ow[buf][j] = ((const u32x2*)(O + (size_t)(row) * D) + lane)[64 * j]; } } while (0)
    if (!MOE_IN) LN_XPRE(0, mb);
#pragma unroll
    for (int k = 0; k < RPW; ++k) { const int m = mb + k;
        f32x4 y[8];
        if (MOE_IN) {
            const int p1 = ((const int*)(meta + META_POS))[2 * m], p2 = ((const int*)(meta + META_POS))[2 * m + 1];
            const f32x2 pr = ((const f32x2*)(meta + META_TOKP))[m];
            const bool t1 = p1 >= 2 * M, t2 = p2 >= 2 * M;
            const u32x2* y1 = t1 ? (const u32x2*)(O2 + (size_t)(p1 - 2 * M) * D) + lane : (const u32x2*)(O + (size_t)p1 * D) + lane;
            const u32x2* y2 = t2 ? (const u32x2*)(O2 + (size_t)(p2 - 2 * M) * D) + lane : (const u32x2*)(O + (size_t)p2 * D) + lane;
            constexpr size_t SL4 = SLAB_ELEMS / 4;
            u32x2 w1[8], w2[8], xv[8];
#pragma unroll
            for (int j = 0; j < 8; ++j) { xv[j] = ((const u32x2*)((const bf16*)xin + (size_t)m * D) + lane)[64 * j]; w1[j] = y1[64 * j]; w2[j] = y2[64 * j]; }
            __builtin_amdgcn_sched_barrier(0);
#pragma unroll
            for (int j = 0; j < 8; ++j) { f32x4 a1 = bf4(w1[j]), a2 = bf4(w2[j]);
                if (t1) a1 = (a1 + bf4(y1[64 * j + SL4])) + (bf4(y1[64 * j + 2 * SL4]) + bf4(y1[64 * j + 3 * SL4]));
                if (t2) a2 = (a2 + bf4(y2[64 * j + SL4])) + (bf4(y2[64 * j + 2 * SL4]) + bf4(y2[64 * j + 3 * SL4]));
                y[j] = DN_ALPHA * bf4(xv[j]) + P[2048 + lane + 64 * j] * (pr.x * a1 + pr.y * a2); }
        } else {
            if (k + 1 < RPW) { LN_XPRE((k + 1) & 1, m + 1); __builtin_amdgcn_sched_barrier(0); }
#pragma unroll
            for (int j = 0; j < 8; ++j) y[j] = DN_ALPHA * (XIN_BF ? bf4(xw[k & 1][j]) : xf[k & 1][j]) + P[2048 + lane + 64 * j] * bf4(ow[k & 1][j]);
        }
        float s = 0.f;
#pragma unroll
        for (int j = 0; j < 8; ++j) s += (y[j][0] + y[j][1]) + (y[j][2] + y[j][3]);
        const float mean = wave_sum(s) * (1.0f / D); float s2 = 0.f;
#pragma unroll
        for (int j = 0; j < 8; ++j) { y[j] = y[j] - mean; s2 += (y[j][0] * y[j][0] + y[j][1] * y[j][1]) + (y[j][2] * y[j][2] + y[j][3] * y[j][3]); }
        const float rstd = 1.0f / sqrtf(wave_sum(s2) * (1.0f / D) + LN_EPS);
        f32x4* xo = (f32x4*)((float*)xout + (size_t)m * D) + lane; u32x2* xob = (u32x2*)((bf16*)xout + (size_t)m * D) + lane;
        float lg[NE];
#pragma unroll
        for (int e = 0; e < NE; ++e) lg[e] = 0.f;
#pragma unroll
        for (int j = 0; j < 8; ++j) { const f32x4 xn = y[j] * rstd * P[lane + 64 * j] + P[512 + lane + 64 * j];
            if (XOUT_BF) { u32x2 w; w.x = cvt_pk_bf16(xn[0], xn[1]); w.y = cvt_pk_bf16(xn[2], xn[3]); xob[64 * j] = w; } else xo[64 * j] = xn;
            if (HAS_NEXT) { const f32x4 hf = xn * P[1536 + lane + 64 * j] + P[1024 + lane + 64 * j];
                if (ROUTER) ((unsigned*)((unsigned char*)hout + (size_t)m * D) + lane)[64 * j] = cvt_pk4_fp8(hf[0] * F8_SA1, hf[1] * F8_SA1, hf[2] * F8_SA1, hf[3] * F8_SA1);
                else y[j] = hf;
                if (ROUTER) {
#pragma unroll
                    for (int q = 0; q < 4; ++q) { const int kk = 4 * lane + 256 * j + q; const f32x4 r0 = *(const LAS f32x4*)(rw + kk * 8), r1 = *(const LAS f32x4*)(rw + kk * 8 + 4);
                        lg[0] += hf[q] * r0[0]; lg[1] += hf[q] * r0[1]; lg[2] += hf[q] * r0[2]; lg[3] += hf[q] * r0[3]; lg[4] += hf[q] * r1[0]; lg[5] += hf[q] * r1[1]; lg[6] += hf[q] * r1[2]; lg[7] += hf[q] * r1[3]; } } } }
        if (HAS_NEXT && !ROUTER) {
            float amax = 0.f;
#pragma unroll
            for (int j = 0; j < 8; ++j) amax = fmaxf(amax, fmaxf(fmaxf(fabsf(y[j][0]), fabsf(y[j][1])), fmaxf(fabsf(y[j][2]), fabsf(y[j][3]))));
#pragma unroll
            for (int o = 1; o < 64; o <<= 1) amax = fmaxf(amax, __shfl_xor(amax, o));
            amax = fmaxf(amax, 1e-20f); const float q = 127.0f / amax;
            if (lane == 0) rs[m] = amax * (1.0f / 127.0f);
#pragma unroll
            for (int j = 0; j < 8; ++j) ((unsigned*)((unsigned char*)hout + (size_t)m * D) + lane)[64 * j] = cvt_pk4_i8(y[j][0] * q, y[j][1] * q, y[j][2] * q, y[j][3] * q);
        }
        if (ROUTER) {
#pragma unroll
            for (int e = 0; e < NE; ++e) lg[e] = wave_sum(lg[e]);
            int e1 = 0; float v1 = lg[0];
#pragma unroll
            for (int e = 1; e < NE; ++e) if (lg[e] > v1) { v1 = lg[e]; e1 = e; }
            int e2 = -1; float v2 = -3.0e38f;
#pragma unroll
            for (int e = 0; e < NE; ++e) if (e != e1 && lg[e] > v2) { v2 = lg[e]; e2 = e; }
            const float ex = __expf(v2 - v1), p1 = 1.0f / (1.0f + ex), p2 = ex / (1.0f + ex);
            if (lane == 0) { ((unsigned*)(meta + META_TOKE))[m] = (unsigned)e1 | ((unsigned)e2 << 8); ((f32x2*)(meta + META_TOKP))[m] = (f32x2){p1, p2}; }
        }
    }
}
#undef LN_XPRE

__device__ __forceinline__ void moe_scatter(const bf16* H, bf16* HS, unsigned char* meta, LAS unsigned char* lds, int bid, int G, int tid, int wave, int lane) {
    LAS unsigned* cnt = (LAS unsigned*)lds;
    LAS int* spos = (LAS int*)(lds + 256);
    LAS int* sbase = (LAS int*)(lds + 1024);
    const unsigned* toke = (const unsigned*)(meta + META_TOKE);
    const int TPW = M / G, blk0 = bid * TPW;
    if (tid < 16) cnt[tid] = 0u;
    __syncthreads();
    { unsigned tot[NE], bef[NE];
#pragma unroll
      for (int e = 0; e < NE; ++e) { tot[e] = 0u; bef[e] = 0u; }
      const int tk0 = tid * 16;
#pragma unroll
      for (int q = 0; q < 4; ++q) { const u32x4 v = *((const u32x4*)(toke + tk0) + q);
#pragma unroll
          for (int j = 0; j < 4; ++j) { const unsigned w = v[j], e1 = w & 0xffu, e2 = (w >> 8) & 0xffu; const bool bf = (tk0 + 4 * q + j) < blk0;
#pragma unroll
              for (int e = 0; e < NE; ++e) { const unsigned hit = (e1 == (unsigned)e) + (e2 == (unsigned)e); tot[e] += hit; bef[e] += bf ? hit : 0u; } } }
#pragma unroll
      for (int e = 0; e < NE; ++e) { unsigned t = tot[e], b2 = bef[e];
#pragma unroll
          for (int o = 1; o < 64; o <<= 1) { t += __shfl_xor(t, o); b2 += __shfl_xor(b2, o); }
          tot[e] = t; bef[e] = b2; }
      if (lane == 0) {
#pragma unroll
          for (int e = 0; e < NE; ++e) { atomicAdd((unsigned*)&cnt[e], tot[e]); atomicAdd((unsigned*)&cnt[8 + e], bef[e]); } }
    }
    __syncthreads();
    if (tid == 0) { int base = 0; for (int e = 0; e < NE; ++e) { sbase[e] = base; sbase[8 + e] = (int)cnt[e]; base += (((int)cnt[e] + 255) >> 8) << 8; } }
    __syncthreads();
    if (wave == 0) {
        const bool act = lane < TPW; const unsigned w = act ? toke[blk0 + lane] : 0xffffu; const unsigned e1 = w & 0xffu, e2 = (w >> 8) & 0xffu;
        int pos1 = 0, pos2 = 0;
#pragma unroll
        for (int e = 0; e < NE; ++e) { const unsigned long long mk = __ballot(act && (e1 == (unsigned)e || e2 == (unsigned)e)); const int rank = __popcll(mk & ((1ull << lane) - 1ull));
            const int p = sbase[e] + (int)cnt[8 + e] + rank; if (e1 == (unsigned)e) pos1 = p; if (e2 == (unsigned)e) pos2 = p; }
        if (act) { spos[2 * lane] = pos1; spos[2 * lane + 1] = pos2; ((int*)(meta + META_POS))[2 * (blk0 + lane)] = pos1; ((int*)(meta + META_POS))[2 * (blk0 + lane) + 1] = pos2; }
    }
    __syncthreads();
#pragma unroll 1
    for (int c0 = wave; c0 < 2 * TPW; c0 += 32) { u32x4 v[4][2];
#pragma unroll
        for (int q = 0; q < 4; ++q) { const int cpy = c0 + 8 * q; const int tk = blk0 + (cpy >> 1); const u32x4* sp = (const u32x4*)((const unsigned char*)H + (size_t)tk * D) + lane;
            if (cpy < 2 * TPW) { v[q][0] = sp[0]; v[q][1] = sp[64]; } }
#pragma unroll
        for (int q = 0; q < 4; ++q) { const int cpy = c0 + 8 * q;
            if (cpy < 2 * TPW) { u32x4* d = (u32x4*)((unsigned char*)HS + (size_t)spos[cpy] * D) + lane; d[0] = v[q][0]; d[64] = v[q][1]; } } }
    for (int e = 0; e < NE; ++e) { const int c = sbase[8 + e], r = c + bid, rend = ((c + 255) >> 8) << 8;
        if (r < rend) { unsigned* d = (unsigned*)((unsigned char*)HS + (size_t)(sbase[e] + r) * D); d[tid] = 0u; } }
    if (bid == 0 && tid == 0) { int* mi = (int*)(meta + META_INTS); int tb = 0; for (int e = 0; e < NE; ++e) { mi[e] = tb; tb += (sbase[8 + e] + 255) >> 8; } mi[8] = tb; }
}

__global__ void __launch_bounds__(512, 2) fwd(Args args) {
    extern __shared__ __attribute__((aligned(16))) unsigned char lds_raw[];
    LAS unsigned char* lds = (LAS unsigned char*)lds_raw;
    unsigned char* ws = args.ws;
    volatile LAS unsigned* MISC = (volatile LAS unsigned*)(lds + LDSCTL_OFF);
    if (threadIdx.x < 64) MISC[threadIdx.x] = 0u;
    const int wave0 = __builtin_amdgcn_readfirstlane((int)threadIdx.x >> 6);
    __syncthreads();
#define IDS() int wave = wave0; asm volatile("" : "+s"(wave)); int bid = blockIdx.x; asm volatile("" : "+s"(bid)); const int G = gridDim.x; \
    const int lane = lane_id_fresh(); const int tid = wave * 64 + lane; const int vcu = (G % 8 == 0) ? (bid % 8) * (G / 8) + bid / 8 : bid; const int gw = vcu * 8 + wave, NGW = G * 8; \
    (void)lane; (void)wave; (void)vcu; (void)gw; (void)NGW; (void)bid; (void)G
    const int lo = args.ph_lo, hi = args.ph_hi;
    XcdBarrier bar; bar.bar = (unsigned*)(ws + WS_CTL) + CW_BAR; bar.x = 0; bar.st = nullptr;
    if (hi - lo > 1) bar = xcd_barrier_post((unsigned*)(ws + WS_CTL) + CW_BAR, MISC + 8);
#ifndef PH_MASK
#define PH_MASK 0xffffffffu
#endif
#define IN(k) (((PH_MASK >> (k)) & 1u) && lo <= (k) && (k) < hi)
#define SEAM(k) do { if (IN((k) + 1)) xcd_barrier(bar, wave0); } while (0)

    float* mod = (float*)(ws + WS_MOD);
    float* X = (float*)(ws + WS_X); bf16* H = (bf16*)(ws + WS_H); bf16* O = (bf16*)(ws + WS_O);
    bf16* Z = (bf16*)(ws + WS_Z); bf16* XC = (bf16*)(ws + WS_XC); bf16* PP = (bf16*)(ws + WS_PP); float* Aa = (float*)(ws + WS_A); float* Uu = (float*)(ws + WS_U); bf16* YCAT = (bf16*)(ws + WS_YCAT);
    unsigned char* meta = ws + WS_META;

    if (IN(0)) { IDS();
        if (bid == G - 1) { for (int i = tid; i < 2 * DLRU; i += 512) { const float t = -args.in[IN_LAM][i]; ((float*)(ws + WS_SP))[i] = -8.0f * (fmaxf(t, 0.f) + log1pf(__expf(-fabsf(t)))); } }
        p0_adaln(args, ws, lds, vcu, G, tid, wave, lane); __syncthreads(); convert_items_bf16(args, ws, lds, 0, T_FD, gw, NGW, wave, lane); convert_items(args, ws, lds, T_FD, T_IN, gw, NGW, wave, lane); p0_absmax(args, (unsigned*)(ws + WS_CTL) + CW_AMAX, lds, gw, NGW, tid, lane); __syncthreads(); SEAM(0); }
    if (IN(1)) { IDS(); p1_mod_rows(args.in[IN_X], mod, H, (float*)(meta + META_RS), gw, NGW, lane); convert_items(args, ws, lds, T_IN, T_FG, gw, NGW, wave, lane); SEAM(1); }


#define MIXER(l, pb) \
        if (IN(pb + 0)) { IDS(); \
            if (bid >= CV_P2_WGS) { convert_items(args, ws, lds, l == 0 ? CV_A0 : CV_B1, l == 0 ? CV_A1 : CV_C1, (bid - CV_P2_WGS) * 8 + wave, (G - CV_P2_WGS) * 8, wave, lane); __syncthreads(); } else { \
            pg8::PlainSched S; S.init_order(M / 256, DIN / 256, CV_P2_WGS, bid); S.A = (const char*)H; S.B = (const char*)(ws + WS_WIN) + (size_t)l * DIN * D; S.a_tile = (size_t)256 * D; S.b_tile = (size_t)256 * D; S.a_sh = 0; S.a_mul = 0u;     \
            pg8::EpiBf16I8 E{Z, DIN, (const float*)(meta + META_RS), (const unsigned*)(ws + WS_CTL) + CW_AMAX + 1 + l}; \
            pg8::gemm_phase<pg8::EpiBf16I8, pg8::PlainSched, 2>(lds, pg8::Gemm{D / 2, D / 2, D / 2}, S, E, wave); } \
            SEAM(pb + 0); \
        } \
          \
        if (IN(pb + 2)) { IDS(); \
            if (bid < G / 2) { const int pmq = bid >> 2, hq = bid & 3; \
              conv_tile(Z, args.in[IN_CONVW] + l * 4 * DLRU, args.in[IN_CONVB] + l * DLRU, XC, pmq, hq, tid); \
              asm volatile("s_waitcnt vmcnt(0)" ::: "memory"); __syncthreads(); \
              pg8::FixedSched S; S.pm = pmq; S.pn0 = 2 * hq; S.n = 2; S.A = (const char*)XC; S.B = (const char*)(ws + WS_WG) + (size_t)l * 2048 * 256 * 2; S.a_tile = (size_t)256 * DLRU * 2; S.b_tile = (size_t)256 * 256 * 2; S.a_sh = 1; S.a_mul = 512u; \
              pg8::EpiGates E{args.in[IN_BA] + l * DLRU, args.in[IN_BX] + l * DLRU, (const float*)(ws + WS_SP) + l * DLRU, XC, (unsigned*)Aa}; \
              pg8::gemm_phase<pg8::EpiGates, pg8::FixedSched>(lds, pg8::Gemm{DLRU, 256, 256}, S, E, wave); } \
            else { const int wq = bid - G / 2, pmq = wq >> 2, gq = wq & 3; \
              pool_tile(Z, PP, pmq, gq, tid); \
              asm volatile("s_waitcnt vmcnt(0)" ::: "memory"); __syncthreads(); \
              pg8::FixedSched S; S.pm = pmq; S.pn0 = gq; S.n = 1; S.A = (const char*)PP; S.B = (const char*)(ws + WS_WP) + (size_t)l * 1024 * 256 * 2; S.a_tile = (size_t)256 * DLRU * 2; S.b_tile = (size_t)256 * 256 * 2; S.a_sh = 0; S.a_mul = 512u; \
              pg8::EpiPool E{YCAT, D, DLRU, args.in[IN_POOLB] + l * DLRU, args.in[IN_POOLS] + l * DLRU}; \
              pg8::gemm_phase<pg8::EpiPool, pg8::FixedSched>(lds, pg8::Gemm{DLRU, 256, 256}, S, E, wave); } \
            SEAM(pb + 2); \
        } \
        if (IN(pb + 3)) { IDS(); p5_scan((const unsigned*)Aa, Z, YCAT, lds, vcu, G, tid); SEAM(pb + 3); } \
        if (IN(pb + 4)) { IDS(); \
            pg8::PlainSched S; S.init_order(M / 256, D / 256, G, bid); S.A = (const char*)YCAT; S.B = (const char*)(ws + WS_WOUT) + (size_t)l * D * D * 2; S.a_tile = (size_t)256 * D * 2; S.b_tile = (size_t)256 * D * 2; S.a_sh = 0; S.a_mul = 0u; \
            if (l == 0) {   \
              pg8::EpiLnFused E{args.in[IN_X], (bf16*)X, (unsigned char*)H, (float*)(meta + META_RS), mod + (size_t)0 * 4 * 3 * D + 2 * D, args.in[IN_LNG] + 0 * D, args.in[IN_LNB] + 0 * D, mod + (size_t)1 * 4 * 3 * D, mod + (size_t)1 * 4 * 3 * D + D, \
                                 (unsigned long long*)(ws + WS_O), (unsigned*)(ws + WS_O + 1048576), (unsigned*)(ws + WS_CTL) + CW_LNC, (unsigned*)(ws + WS_CTL) + CW_LNC + 2048, lds}; \
              pg8::gemm_phase<pg8::EpiLnFused, pg8::PlainSched>(lds, pg8::Gemm{D, D, D}, S, E, wave); \
            } else { \
            pg8::EpiBf16 E{O, D, 0, 0, 1.0f}; \
            pg8::gemm_phase<pg8::EpiBf16, pg8::PlainSched>(lds, pg8::Gemm{D, D, D}, S, E, wave); } \
            SEAM(pb + 4); \
        }

    MIXER(0, 2)
    if (IN(8)) { IDS();
        if (bid >= CV_P8_WGS) { convert_items(args, ws, lds, CV_A1, CV_B1, (bid - CV_P8_WGS) * 8 + wave, (G - CV_P8_WGS) * 8, wave, lane); __syncthreads(); } else {
        pg8::PlainSched S; S.init_order(M / 256, 2 * DFF / 256, CV_P8_WGS, bid); S.A = (const char*)H; S.B = (const char*)(ws + WS_WGU); S.a_tile = (size_t)256 * D; S.b_tile = (size_t)256 * D; S.a_sh = 0; S.a_mul = 0u;
        pg8::EpiSwigluI8F8 E{(bf16*)(ws + WS_HID), DFF, (const float*)(meta + META_RS), (const unsigned*)(ws + WS_CTL) + CW_AMAX};
        pg8::gemm_phase<pg8::EpiSwigluI8F8, pg8::PlainSched, 2>(lds, pg8::Gemm{D / 2, D / 2, D / 2}, S, E, wave); }
        SEAM(8);
    }
    if (IN(9)) { IDS();
        pg8::PlainSched S; S.init_order(M / 256, D / 256, G, bid); S.A = (const char*)(ws + WS_HID); S.B = (const char*)(ws + WS_WD); S.a_tile = (size_t)256 * DFF; S.b_tile = (size_t)256 * DFF; S.a_sh = 0; S.a_mul = 0u;
        pg8::EpiLnFusedB E{(const float*)X, (bf16*)X, (unsigned char*)H, (float*)(meta + META_RS), mod + (size_t)1 * 4 * 3 * D + 2 * D, args.in[IN_LNG] + 1 * D, args.in[IN_LNB] + 1 * D, mod + (size_t)2 * 4 * 3 * D, mod + (size_t)2 * 4 * 3 * D + D,
                            (unsigned long long*)(ws + WS_O), (unsigned*)(ws + WS_O + 1048576), (unsigned*)(ws + WS_CTL) + CW_LNC + 4096, (unsigned*)(ws + WS_CTL) + CW_LNC + 4096 + 2048, lds};
        pg8::gemm_phase<pg8::EpiLnFusedB, pg8::PlainSched, 1>(lds, pg8::Gemm{DFF / 2, DFF / 2, DFF / 2}, S, E, wave);
        SEAM(9);
    }
    MIXER(1, 11)
    if (IN(16)) { IDS();
        ln_phase_row<false, true, true, true, true>(X, X, O, nullptr, mod + (size_t)2 * 4 * 3 * D, args.in[IN_LNG] + 2 * D, args.in[IN_LNB] + 2 * D, mod + (size_t)3 * 4 * 3 * D, H, args.in[IN_ROUTER], nullptr, meta, lds, gw, NGW, tid, lane);
        SEAM(16);
    }
    if (IN(17)) { IDS(); moe_scatter(H, (bf16*)(ws + WS_HS), meta, lds, bid, G, tid, wave, lane); __syncthreads(); convert_items(args, ws, lds, CV_C1, T_END, gw, NGW, wave, lane); __syncthreads(); SEAM(17); }
    if (IN(18)) { IDS();
        int tbv[9];
#pragma unroll
        for (int e = 0; e < 9; ++e) tbv[e] = __builtin_amdgcn_readfirstlane((int)__hip_atomic_load((unsigned*)(meta + META_INTS) + e, __ATOMIC_RELAXED, __HIP_MEMORY_SCOPE_AGENT));
        pg8::MoeSched S; S.init_order(tbv[8], 2 * DFE / 256, G, bid); S.A = (const char*)(ws + WS_HS); S.B = (const char*)(ws + WS_WEGU); S.a_tile = (size_t)256 * D; S.b_tile = (size_t)256 * D; S.b_exp = (size_t)2 * DFE * D;
        S.tb1 = tbv[1]; S.tb2 = tbv[2]; S.tb3 = tbv[3]; S.tb4 = tbv[4]; S.tb5 = tbv[5]; S.tb6 = tbv[6]; S.tb7 = tbv[7];
        pg8::EpiSwigluF8 E{ws + WS_HIDS, DFE, 1.0f / (F8_SA1 * F8_SB1), F8_SH};
        pg8::gemm_phase<pg8::EpiSwigluF8, pg8::MoeSched, 1>(lds, pg8::Gemm{D / 2, D / 2, D / 2}, S, E, wave);
        SEAM(18);
    }
    if (IN(19)) { IDS();
        int tbv[9];
#pragma unroll
        for (int e = 0; e < 9; ++e) tbv[e] = __builtin_amdgcn_readfirstlane((int)__hip_atomic_load((unsigned*)(meta + META_INTS) + e, __ATOMIC_RELAXED, __HIP_MEMORY_SCOPE_AGENT));
        const int Tm = tbv[8] < 64 ? tbv[8] : 64;
        { pg8::MoeSched S; S.init_order(Tm, D / 256, G, bid); S.A = (const char*)(ws + WS_HIDS); S.B = (const char*)(ws + WS_WED); S.a_tile = (size_t)256 * DFE; S.b_tile = (size_t)256 * DFE; S.b_exp = (size_t)D * DFE;
          S.tb1 = tbv[1]; S.tb2 = tbv[2]; S.tb3 = tbv[3]; S.tb4 = tbv[4]; S.tb5 = tbv[5]; S.tb6 = tbv[6]; S.tb7 = tbv[7];
          pg8::EpiBf16 E{(bf16*)(ws + WS_YBUF), D, 0, 0, 1.0f / (F8_SH * F8_SB2)};
          pg8::gemm_phase<pg8::EpiBf16, pg8::MoeSched, 1>(lds, pg8::Gemm{DFE / 2, DFE / 2, DFE / 2}, S, E, wave); }
        if (tbv[8] > 64) {
          pg8::MoeTailSched S; S.pm0 = 64; S.nsub = (tbv[8] - 64) * 8 * 4; S.G = G; S.c = bid; S.A = (const char*)(ws + WS_HIDS); S.B = (const char*)(ws + WS_WED); S.a_tile = (size_t)256 * DFE; S.b_tile = (size_t)256 * DFE; S.b_exp = (size_t)D * DFE; S.kslice = (size_t)(DFE / 4); S.bslice = (size_t)(DFE / 4) * 256;
          S.tb1 = tbv[1]; S.tb2 = tbv[2]; S.tb3 = tbv[3]; S.tb4 = tbv[4]; S.tb5 = tbv[5]; S.tb6 = tbv[6]; S.tb7 = tbv[7];
          pg8::EpiBf16 E{(bf16*)(ws + WS_SLAB), D, SLAB_ELEMS, 64, 1.0f / (F8_SH * F8_SB2)};
          pg8::gemm_phase<pg8::EpiBf16, pg8::MoeTailSched, 1>(lds, pg8::Gemm{DFE / 2, DFE / 2, DFE / 8}, S, E, wave); }
        SEAM(19);
    }
    if (IN(20)) { IDS();
        ln_phase_row<true, false, false, true, false>(X, args.out, (const bf16*)(ws + WS_YBUF), (const bf16*)(ws + WS_SLAB), mod + (size_t)3 * 4 * 3 * D, args.in[IN_LNG] + 3 * D, args.in[IN_LNB] + 3 * D, nullptr, nullptr, nullptr, nullptr, meta, lds, gw, NGW, tid, lane);
    }
#undef MIXER
#undef IN
#undef SEAM
}

extern "C" void kernel_launch(void* const* d_in, const int* in_sizes, int n_in, void* d_out, int out_size, void* d_ws, size_t ws_size, hipStream_t stream) {
    static int grid = 0;
    if (grid == 0) {
        if (n_in != 25 || out_size != M * D || ws_size < WS_END) { fprintf(stderr, "kernel_launch: unexpected sizes (n_in %d, out %d, ws %zu < %zu)\n", n_in, out_size, ws_size, (size_t)WS_END); grid = -1; return; }
        if (hipFuncSetAttribute((const void*)fwd, hipFuncAttributeMaxDynamicSharedMemorySize, LDS_BYTES) != hipSuccess) { fprintf(stderr, "kernel_launch: hipFuncSetAttribute failed\n"); grid = -1; return; }
        int dev = 0, cus = 0, per_cu = 0;
        (void)hipGetDevice(&dev); (void)hipDeviceGetAttribute(&cus, hipDeviceAttributeMultiprocessorCount, dev);
        if (hipOccupancyMaxActiveBlocksPerMultiprocessor(&per_cu, (const void*)fwd, 512, LDS_BYTES) != hipSuccess || per_cu < 1) fprintf(stderr, "kernel_launch: occupancy query reports %d\n", per_cu);
        (void)hipGetLastError();
        grid = 256;
        if (cus != 256) fprintf(stderr, "kernel_launch: device reports %d CUs; this kernel is built for 256\n", cus);
    }
    if (grid < 0) return;
    (void)hipMemsetAsync((char*)d_ws + WS_CTL, 0, CTL_ZERO_BYTES, stream);
    Args a{};
    for (int i = 0; i < 25; ++i) a.in[i] = (const float*)d_in[i];
    a.out = (float*)d_out; a.ws = (unsigned char*)d_ws;
#if MK_ONE_LAUNCH
    a.ph_lo = 0; a.ph_hi = NPHASE;
    hipLaunchKernelGGL(fwd, dim3(grid), dim3(512), LDS_BYTES, stream, a);
#else
#ifndef DUP_MASK
#define DUP_MASK 0u
#endif
    for (int p = 0; p < NPHASE; ++p) { a.ph_lo = p; a.ph_hi = p + 1; const int reps = ((DUP_MASK >> p) & 1u) ? 2 : 1;
        for (int r = 0; r < reps; ++r) hipLaunchKernelGGL(fwd, dim3(grid), dim3(512), LDS_BYTES, stream, a); }
#endif
}
```

```cpp
#include <hip/hip_runtime.h>
#include <cstdio>
#include <cstdint>

#ifndef MK_ONE_LAUNCH
#define MK_ONE_LAUNCH 1
#endif

constexpr int D = 2048, NB = 4, SEQ = 2048, M = NB * SEQ;
constexpr int DLRU = 1024, DIN = 3072, DFF = 5632, NE = 8, DFE = 7168;
constexpr int MOE_ROWS = 2 * M + NE * 256;
constexpr float LN_EPS = 1e-5f;
constexpr float DN_ALPHA = 1.41421356237309515f;
constexpr int NPHASE = 21;

#define GAS __attribute__((address_space(1)))
#define LAS __attribute__((address_space(3)))
typedef unsigned short bf16;
typedef float f32x4 __attribute__((ext_vector_type(4)));
typedef float f32x2 __attribute__((ext_vector_type(2)));
typedef unsigned u32x4 __attribute__((ext_vector_type(4)));
typedef unsigned u32x2 __attribute__((ext_vector_type(2)));
typedef short bf16x8 __attribute__((ext_vector_type(8)));

__device__ __forceinline__ unsigned cvt_pk_bf16(float lo, float hi) { unsigned r; asm volatile("v_cvt_pk_bf16_f32 %0, %1, %2" : "=v"(r) : "v"(lo), "v"(hi)); return r; }
__device__ __forceinline__ int lane_id_fresh() { int l; asm volatile("v_mbcnt_lo_u32_b32 %0, -1, 0\n\tv_mbcnt_hi_u32_b32 %0, -1, %0" : "=v"(l)); return l; }
__device__ __forceinline__ unsigned cvt_pk4_fp8(float a, float b, float c, float d) {
    a = __builtin_amdgcn_fmed3f(a, -448.f, 448.f); b = __builtin_amdgcn_fmed3f(b, -448.f, 448.f); c = __builtin_amdgcn_fmed3f(c, -448.f, 448.f); d = __builtin_amdgcn_fmed3f(d, -448.f, 448.f);
    int w = __builtin_amdgcn_cvt_pk_fp8_f32(a, b, 0, false); w = __builtin_amdgcn_cvt_pk_fp8_f32(c, d, w, true); return (unsigned)w;
}
__device__ __forceinline__ unsigned cvt_pk4_i8(float a, float b, float c, float d) {
    const int q0 = (int)__builtin_rintf(__builtin_amdgcn_fmed3f(a, -127.f, 127.f)), q1 = (int)__builtin_rintf(__builtin_amdgcn_fmed3f(b, -127.f, 127.f));
    const int q2 = (int)__builtin_rintf(__builtin_amdgcn_fmed3f(c, -127.f, 127.f)), q3 = (int)__builtin_rintf(__builtin_amdgcn_fmed3f(d, -127.f, 127.f));
    return (unsigned)(q0 & 255) | ((unsigned)(q1 & 255) << 8) | ((unsigned)(q2 & 255) << 16) | ((unsigned)q3 << 24);
}
constexpr float F8_SA1 = 16.f, F8_SB1 = 64.f, F8_SH = 8.f, F8_SB2 = 256.f;
__device__ __forceinline__ float bf_lo(unsigned w) { return __uint_as_float(w << 16); }
__device__ __forceinline__ float bf_hi(unsigned w) { return __uint_as_float(w & 0xffff0000u); }
__device__ __forceinline__ f32x4 bf4(u32x2 w) { return (f32x4){bf_lo(w.x), bf_hi(w.x), bf_lo(w.y), bf_hi(w.y)}; }
__device__ __forceinline__ float fast_sigmoid(float v) { return __builtin_amdgcn_rcpf(1.0f + __expf(-v)); }
__device__ __forceinline__ float gelu_tanh(float v) {
    const float t = 0.7978845608028654f * (v + 0.044715f * v * v * v);
    return v * fast_sigmoid(2.0f * t);
}

namespace pg8 {
#define PG8_LAS __attribute__((address_space(3)))
constexpr int BM = 256, BK = 64, HALF = 128, HTB = HALF * BK * 2  , STAGE_BYTES = 8 * HTB, NXCD = 8, WGM = 8;

__host__ __device__ __forceinline__ int lds_byte(int r, int c) { const int st = (r >> 4) * 2 + (c >> 5), rr = r & 15, cc = c & 31, ob = rr * 64 + cc * 2; return st * 1024 + (ob ^ (((ob >> 9) & 1) << 5)); }
__host__ __device__ __forceinline__ void stage_rc(int b, int& R, int& C) { const int st = b / 1024, sb = b % 1024, swz = sb ^ (((sb >> 9) & 1) << 5); R = (st >> 1) * 16 + swz / 64; C = (st & 1) * 32 + (swz % 64) / 2; }
__host__ __device__ __forceinline__ int perm32(int rho) { const int n = rho >> 4, i = rho & 15; return 8 * (i >> 2) + 4 * n + (i & 3); }

typedef int i32x4v __attribute__((ext_vector_type(4)));
typedef int i32x8v __attribute__((ext_vector_type(8)));
struct Unit { int pm, pn, ks; };
struct Gemm { int lda, ldb, K; };

struct TileOrder {
    int nM, nN, nwg, G, c;
    __device__ __forceinline__ void init_order(int nM_, int nN_, int G_, int c_) { nM = nM_; nN = nN_; nwg = nM * nN; G = G_; c = c_; }
    __device__ __forceinline__ bool next(int i, Unit& u) const {
        const long L = (long)i * G + c; if (L >= nwg) return false;
        int wgid = (int)L; { const int q = nwg / NXCD, r = nwg % NXCD, xcd = wgid % NXCD, off = wgid / NXCD; wgid = (xcd < r ? xcd * (q + 1) : r * (q + 1) + (xcd - r) * q) + off; }
        const int nig = WGM * nN, gid = wgid / nig, fm = gid * WGM, gsz = (nM - fm) < WGM ? (nM - fm) : WGM;
        u.pm = fm + ((wgid % nig) % gsz); u.pn = (wgid % nig) / gsz; u.ks = 0; return true;
    }
    __device__ __forceinline__ void a_ready(const Unit&) const {}
    __device__ __forceinline__ void done(const Unit&) const {}
};
struct PlainSched : TileOrder {
    const char* A; const char* B; size_t a_tile, b_tile; int a_sh; unsigned a_mul;
    __device__ __forceinline__ const char* a_base(const Unit& u) const { return A + (size_t)u.pm * a_tile + (size_t)((unsigned)(u.pn >> a_sh) * a_mul); }
    __device__ __forceinline__ const char* b_base(const Unit& u) const { return B + (size_t)u.pn * b_tile; }
};
struct FixedSched {
    int pm, pn0, n; const char* A; const char* B; size_t a_tile, b_tile; int a_sh; unsigned a_mul;
    __device__ __forceinline__ bool next(int i, Unit& u) const { if (i >= n) return false; u.pm = pm; u.pn = pn0 + i; u.ks = 0; return true; }
    __device__ __forceinline__ const char* a_base(const Unit& u) const { return A + (size_t)u.pm * a_tile + (size_t)((unsigned)(u.pn >> a_sh) * a_mul); }
    __device__ __forceinline__ const char* b_base(const Unit& u) const { return B + (size_t)u.pn * b_tile; }
    __device__ __forceinline__ void a_ready(const Unit&) const {}
    __device__ __forceinline__ void done(const Unit&) const {}
};
struct MoeSched {
    int nM, nN, nwg, G, c;
    const char* A; const char* B; size_t a_tile, b_tile, b_exp; int tb1, tb2, tb3, tb4, tb5, tb6, tb7;
    __device__ __forceinline__ void init_order(int nM_, int nN_, int G_, int c_) { nM = nM_; nN = nN_; nwg = nM * nN; G = G_; c = c_; }
    __device__ __forceinline__ int clip(int t) const { return t < nM ? t : nM; }
    __device__ __forceinline__ int expert(int pm) const { return __builtin_amdgcn_readfirstlane((pm >= tb1) + (pm >= tb2) + (pm >= tb3) + (pm >= tb4) + (pm >= tb5) + (pm >= tb6) + (pm >= tb7)); }
    __device__ __forceinline__ bool next(int i, Unit& u) const {
        const long L = (long)i * G + c; if (L >= nwg) return false;
        int wgid = (int)L; { const int q = nwg / NXCD, r = nwg % NXCD, xcd = wgid % NXCD, off = wgid / NXCD; wgid = (xcd < r ? xcd * (q + 1) : r * (q + 1) + (xcd - r) * q) + off; }
        const int b1 = clip(tb1), b2 = clip(tb2), b3 = clip(tb3), b4 = clip(tb4), b5 = clip(tb5), b6 = clip(tb6), b7 = clip(tb7);
        int lo = 0, hi = b1;
        if (wgid >= b1 * nN) { lo = b1; hi = b2; } if (wgid >= b2 * nN) { lo = b2; hi = b3; } if (wgid >= b3 * nN) { lo = b3; hi = b4; } if (wgid >= b4 * nN) { lo = b4; hi = b5; }
        if (wgid >= b5 * nN) { lo = b5; hi = b6; } if (wgid >= b6 * nN) { lo = b6; hi = b7; } if (wgid >= b7 * nN) { lo = b7; hi = nM; }
        const int local = wgid - lo * nN, gsz = hi - lo;
        u.pm = __builtin_amdgcn_readfirstlane(lo + local % gsz); u.pn = __builtin_amdgcn_readfirstlane(local / gsz); u.ks = 0; return true;
    }
    __device__ __forceinline__ const char* a_base(const Unit& u) const { return A + (size_t)u.pm * a_tile; }
    __device__ __forceinline__ const char* b_base(const Unit& u) const { return B + (size_t)expert(u.pm) * b_exp + (size_t)u.pn * b_tile; }
    __device__ __forceinline__ void a_ready(const Unit&) const {}
    __device__ __forceinline__ void done(const Unit&) const {}
};
struct MoeTailSched {
    int pm0, nsub, G, c; const char* A; const char* B; size_t a_tile, b_tile, b_exp, kslice, bslice; int tb1, tb2, tb3, tb4, tb5, tb6, tb7;
    __device__ __forceinline__ bool next(int i, Unit& u) const { const int j = i * G + c; if (j >= nsub) return false; const int un = j >> 2; u.ks = j & 3; u.pm = pm0 + (un >> 3); u.pn = un & 7; return true; }
    __device__ __forceinline__ int expert(int pm) const { return __builtin_amdgcn_readfirstlane((pm >= tb1) + (pm >= tb2) + (pm >= tb3) + (pm >= tb4) + (pm >= tb5) + (pm >= tb6) + (pm >= tb7)); }
    __device__ __forceinline__ const char* a_base(const Unit& u) const { return A + (size_t)u.pm * a_tile + (size_t)u.ks * kslice; }
    __device__ __forceinline__ const char* b_base(const Unit& u) const { return B + (size_t)expert(u.pm) * b_exp + (size_t)u.pn * b_tile + (size_t)u.ks * bslice; }
    __device__ __forceinline__ void a_ready(const Unit&) const {}
    __device__ __forceinline__ void done(const Unit&) const {}
};

struct EpiF32 {
    static constexpr bool PERM = false;
    float* C; int ldc;
    __device__ __forceinline__ void operator()(const f32x4 (&acc)[2][2][4][2], const Unit& u, int wr, int wc, int fr, int fq) const {
        const int row0 = u.pm * BM + wr * 64 + fr, col0 = u.pn * BM + wc * 32 + 4 * fq;
#pragma unroll
        for (int ai = 0; ai < 2; ++ai)
#pragma unroll
            for (int m = 0; m < 4; ++m) { float* rowp = C + (size_t)(row0 + ai * HALF + m * 16) * ldc + col0;
#pragma unroll
                for (int bj = 0; bj < 2; ++bj)
#pragma unroll
                    for (int n = 0; n < 2; ++n) *(f32x4*)(rowp + bj * HALF + n * 16) = acc[ai][bj][m][n]; }
    }
};
struct EpiF32Slab {
    static constexpr bool PERM = false;
    float* C; int ldc; size_t slab; int pm0;
    __device__ __forceinline__ void operator()(const f32x4 (&acc)[2][2][4][2], const Unit& u, int wr, int wc, int fr, int fq) const {
        const int row0 = (u.pm - pm0) * BM + wr * 64 + fr, col0 = u.pn * BM + wc * 32 + 4 * fq; float* base = C + (size_t)u.ks * slab;
#pragma unroll
        for (int ai = 0; ai < 2; ++ai)
#pragma unroll
            for (int m = 0; m < 4; ++m) { float* rowp = base + (size_t)(row0 + ai * HALF + m * 16) * ldc + col0;
#pragma unroll
                for (int bj = 0; bj < 2; ++bj)
#pragma unroll
                    for (int n = 0; n < 2; ++n) *(f32x4*)(rowp + bj * HALF + n * 16) = acc[ai][bj][m][n]; }
    }
};
struct EpiBf16 {
    static constexpr bool PERM = true;
    bf16* O; int ldc; size_t slab; int pm0; float scale;
    __device__ __forceinline__ void operator()(const f32x4 (&acc)[2][2][4][2], const Unit& u, int wr, int wc, int fr, int fq) const {
        const int row0 = (u.pm - pm0) * BM + wr * 64 + fr, col0 = u.pn * BM + wc * 32 + 8 * fq; bf16* base = O + (size_t)u.ks * slab;
#pragma unroll
        for (int ai = 0; ai < 2; ++ai)
#pragma unroll
            for (int m = 0; m < 4; ++m) { bf16* rowp = base + (size_t)(row0 + ai * HALF + m * 16) * ldc + col0;
#pragma unroll
                for (int bj = 0; bj < 2; ++bj) { const f32x4 v0 = acc[ai][bj][m][0] * scale, v1 = acc[ai][bj][m][1] * scale;
                    u32x4 w; w.x = cvt_pk_bf16(v0[0], v0[1]); w.y = cvt_pk_bf16(v0[2], v0[3]); w.z = cvt_pk_bf16(v1[0], v1[1]); w.w = cvt_pk_bf16(v1[2], v1[3]);
                    *(u32x4*)(rowp + bj * HALF) = w; } }
    }
};
struct EpiSwiglu {
    static constexpr bool PERM = true;
    bf16* O; int ldc;
    __device__ __forceinline__ void operator()(const f32x4 (&acc)[2][2][4][2], const Unit& u, int wr, int wc, int fr, int fq) const {
        const int row0 = u.pm * BM + wr * 64 + fr, col0 = u.pn * HALF + wc * 32 + 8 * fq;
#pragma unroll
        for (int ai = 0; ai < 2; ++ai)
#pragma unroll
            for (int m = 0; m < 4; ++m) { bf16* rowp = O + (size_t)(row0 + ai * HALF + m * 16) * ldc + col0;
                f32x4 v[2];
#pragma unroll
                for (int n = 0; n < 2; ++n) { const f32x4 g = acc[ai][0][m][n], up = acc[ai][1][m][n];
#pragma unroll
                    for (int j = 0; j < 4; ++j) v[n][j] = g[j] * up[j] * fast_sigmoid(g[j]); }
                u32x4 w; w.x = cvt_pk_bf16(v[0][0], v[0][1]); w.y = cvt_pk_bf16(v[0][2], v[0][3]); w.z = cvt_pk_bf16(v[1][0], v[1][1]); w.w = cvt_pk_bf16(v[1][2], v[1][3]);
                *(u32x4*)rowp = w; }
    }
};
struct EpiSwigluF8 {
    static constexpr bool PERM = true;
    unsigned char* O; int ldc; float inv, oscale;
    __device__ __forceinline__ void operator()(const f32x4 (&acc)[2][2][4][2], const Unit& u, int wr, int wc, int fr, int fq) const {
        const int row0 = u.pm * BM + wr * 64 + fr, col0 = u.pn * HALF + wc * 32 + 8 * fq;
#pragma unroll
        for (int ai = 0; ai < 2; ++ai)
#pragma unroll
            for (int m = 0; m < 4; ++m) { unsigned char* rowp = O + (size_t)(row0 + ai * HALF + m * 16) * ldc + col0;
                f32x4 v[2];
#pragma unroll
                for (int n = 0; n < 2; ++n) {
                    const f32x4 ex = acc[ai][0][m][n] * (-1.4426950408889634f * inv), pr = (acc[ai][0][m][n] * acc[ai][1][m][n]) * (inv * inv * oscale);
                    f32x4 t;
#pragma unroll
                    for (int j = 0; j < 4; ++j) t[j] = __builtin_amdgcn_exp2f(ex[j]);
                    t = t + 1.0f;
#pragma unroll
                    for (int j = 0; j < 4; ++j) t[j] = __builtin_amdgcn_rcpf(t[j]);
                    v[n] = pr * t; }
                u32x2 w; w.x = cvt_pk4_fp8(v[0][0], v[0][1], v[0][2], v[0][3]); w.y = cvt_pk4_fp8(v[1][0], v[1][1], v[1][2], v[1][3]);
                *(u32x2*)rowp = w; }
    }
};
struct EpiBf16I8 {
    static constexpr bool PERM = true;
    bf16* O; int ldc; const float* rs; const unsigned* amax_bits;
    __device__ __forceinline__ void operator()(const f32x4 (&acc)[2][2][4][2], const Unit& u, int wr, int wc, int fr, int fq) const {
        const int row0 = u.pm * BM + wr * 64 + fr, col0 = u.pn * BM + wc * 32 + 8 * fq;
        const float wsc = __uint_as_float(*amax_bits) * (1.0f / 127.0f);
        float rsv[8];
#pragma unroll
        for (int i = 0; i < 8; ++i) rsv[i] = rs[row0 + (i >> 2) * HALF + (i & 3) * 16];
#pragma unroll
        for (int ai = 0; ai < 2; ++ai)
#pragma unroll
            for (int m = 0; m < 4; ++m) { const int row = row0 + ai * HALF + m * 16; bf16* rowp = O + (size_t)row * ldc + col0; const float sc = rsv[ai * 4 + m] * wsc;
#pragma unroll
                for (int bj = 0; bj < 2; ++bj) { const i32x4v a0 = __builtin_bit_cast(i32x4v, acc[ai][bj][m][0]), a1 = __builtin_bit_cast(i32x4v, acc[ai][bj][m][1]);
                    u32x4 w; w.x = cvt_pk_bf16((float)a0[0] * sc, (float)a0[1] * sc); w.y = cvt_pk_bf16((float)a0[2] * sc, (float)a0[3] * sc); w.z = cvt_pk_bf16((float)a1[0] * sc, (float)a1[1] * sc); w.w = cvt_pk_bf16((float)a1[2] * sc, (float)a1[3] * sc);
                    *(u32x4*)(rowp + bj * HALF) = w; } }
    }
};
template <bool OUT_F8> struct EpiSwigluI8T {
    static constexpr bool PERM = true;
    bf16* O; int ldc; const float* rs; const unsigned* amax_bits;
    __device__ __forceinline__ void operator()(const f32x4 (&acc)[2][2][4][2], const Unit& u, int wr, int wc, int fr, int fq) const {
        const int row0 = u.pm * BM + wr * 64 + fr, col0 = u.pn * HALF + wc * 32 + 8 * fq;
        const float wsc = __uint_as_float(*amax_bits) * (1.0f / 127.0f);
        float rsv[8];
#pragma unroll
        for (int i = 0; i < 8; ++i) rsv[i] = rs[row0 + (i >> 2) * HALF + (i & 3) * 16];
#pragma unroll
        for (int ai = 0; ai < 2; ++ai)
#pragma unroll
            for (int m = 0; m < 4; ++m) { const int row = row0 + ai * HALF + m * 16; bf16* rowp = O + (size_t)row * ldc + col0; const float sc = rsv[ai * 4 + m] * wsc;
                f32x4 v[2];
#pragma unroll
                for (int n = 0; n < 2; ++n) { const i32x4v gi = __builtin_bit_cast(i32x4v, acc[ai][0][m][n]), ui = __builtin_bit_cast(i32x4v, acc[ai][1][m][n]);
                    f32x4 gf, uf;
#pragma unroll
                    for (int j = 0; j < 4; ++j) { gf[j] = (float)gi[j]; uf[j] = (float)ui[j]; }
                    const f32x4 ex = gf * (-1.4426950408889634f * sc), pr = (gf * uf) * (OUT_F8 ? sc * sc * F8_SH : sc * sc);
                    f32x4 t;
#pragma unroll
                    for (int j = 0; j < 4; ++j) t[j] = __builtin_amdgcn_exp2f(ex[j]);
                    t = t + 1.0f;
#pragma unroll
                    for (int j = 0; j < 4; ++j) t[j] = __builtin_amdgcn_rcpf(t[j]);
                    v[n] = pr * t; }
                if (OUT_F8) { u32x2 w; w.x = cvt_pk4_fp8(v[0][0], v[0][1], v[0][2], v[0][3]); w.y = cvt_pk4_fp8(v[1][0], v[1][1], v[1][2], v[1][3]);
                    *(u32x2*)((unsigned char*)O + (size_t)row * ldc + col0) = w; }
                else { u32x4 w; w.x = cvt_pk_bf16(v[0][0], v[0][1]); w.y = cvt_pk_bf16(v[0][2], v[0][3]); w.z = cvt_pk_bf16(v[1][0], v[1][1]); w.w = cvt_pk_bf16(v[1][2], v[1][3]);
                    *(u32x4*)rowp = w; } }
    }
};
typedef EpiSwigluI8T<false> EpiSwigluI8; typedef EpiSwigluI8T<true> EpiSwigluI8F8;
struct EpiGates {
    static constexpr bool PERM = false;
    const float* ba; const float* bx; const float* sp  ; const bf16* xc; unsigned* AU;
    __device__ __forceinline__ void operator()(const f32x4 (&acc)[2][2][4][2], const Unit& u, int wr, int wc, int fr, int fq) const {
        const int row0 = u.pm * BM + wr * 64 + fr, ch0 = u.pn * HALF + wc * 32 + 4 * fq;
        f32x4 bav[2], bxv[2], spv[2];
#pragma unroll
        for (int n = 0; n < 2; ++n) { bav[n] = *(const f32x4*)(ba + ch0 + n * 16); bxv[n] = *(const f32x4*)(bx + ch0 + n * 16); spv[n] = *(const f32x4*)(sp + ch0 + n * 16); }
        u32x2 xwv[8][2];
#pragma unroll
        for (int i = 0; i < 8; ++i)
#pragma unroll
            for (int n = 0; n < 2; ++n) xwv[i][n] = *(const u32x2*)(xc + (size_t)(row0 + (i >> 2) * HALF + (i & 3) * 16) * DLRU + ch0 + n * 16);
        asm volatile("" ::: "memory");
#pragma unroll
        for (int ai = 0; ai < 2; ++ai)
#pragma unroll
            for (int m = 0; m < 4; ++m) { const size_t ro = (size_t)(row0 + ai * HALF + m * 16) * DLRU + ch0;
#pragma unroll
                for (int n = 0; n < 2; ++n) {
                    const f32x4 xa = acc[ai][0][m][n] + bav[n], xx = acc[ai][1][m][n] + bxv[n];
                    const u32x2 xw = xwv[ai * 4 + m][n]; const f32x4 xv = bf4(xw);
                    f32x4 ea = xa * -1.4426950408889634f;
#pragma unroll
                    for (int j = 0; j < 4; ++j) ea[j] = __builtin_amdgcn_exp2f(ea[j]);
                    ea = ea + 1.0f;
#pragma unroll
                    for (int j = 0; j < 4; ++j) ea[j] = __builtin_amdgcn_rcpf(ea[j]);
                    const f32x4 la = spv[n] * ea;
                    f32x4 a = la * 1.4426950408889634f;
#pragma unroll
                    for (int j = 0; j < 4; ++j) a[j] = __builtin_amdgcn_exp2f(a[j]);
                    f32x4 om = 1.0f - a * a;
#pragma unroll
                    for (int j = 0; j < 4; ++j) om[j] = fmaxf(om[j], 1.0e-30f);
                    f32x4 t = xx * -1.4426950408889634f;
#pragma unroll
                    for (int j = 0; j < 4; ++j) t[j] = __builtin_amdgcn_exp2f(t[j]);
                    t = t + 1.0f;
                    f32x4 r = om * t * t;
#pragma unroll
                    for (int j = 0; j < 4; ++j) r[j] = __builtin_amdgcn_rsqf(r[j]);
                    const f32x4 uu = xv * om * r;
                    u32x4 w;
#pragma unroll
                    for (int j = 0; j < 4; ++j) w[j] = cvt_pk_bf16(la[j], uu[j]);
                    *(u32x4*)(AU + ro + n * 16) = w; }
                asm volatile("" ::: "memory"); }
    }
};
struct EpiLnFused {
    static constexpr bool PERM = true;
    const float* xin; bf16* xout; unsigned char* hout; float* rs;
    const float* gate; const float* lng; const float* lnb; const float* shift; const float* scale;
    unsigned long long* xb1; unsigned* xb2; unsigned* cnt1; unsigned* cnt2; PG8_LAS unsigned char* lds;
    __device__ __forceinline__ bool wait_cnt(unsigned* c) const {
        bool ok = false;
        for (int it = 0; it < 400000; ++it) { if ((unsigned)__builtin_amdgcn_readfirstlane(__hip_atomic_load(c, __ATOMIC_RELAXED, __HIP_MEMORY_SCOPE_AGENT)) >= 32u) { ok = true; break; } __builtin_amdgcn_s_sleep(2); }
        return ok;
    }
    __device__ __forceinline__ void operator()(f32x4 (&acc)[2][2][4][2], const Unit& u, int wr, int wc, int fr, int fq) const {
        constexpr int DD = 2048;
        const int wid = wr * 4 + wc, lane = fr + 16 * fq, tid = wid * 64 + lane;
        PG8_LAS f32x2* P = (PG8_LAS f32x2*)(lds + 131072 + 1024);
        PG8_LAS f32x2* S = P + 1024;
        const int b = u.pm >> 3, col0 = u.pn * 256 + wc * 32 + 8 * fq, row0 = u.pm * 256 + wr * 64 + fr;
        { f32x4 gv[2][2];
#pragma unroll
          for (int bj = 0; bj < 2; ++bj)
#pragma unroll
              for (int n = 0; n < 2; ++n) gv[bj][n] = *(const f32x4*)(gate + (size_t)b * 3 * DD + col0 + bj * 128 + 4 * n) + 1.0f;
#pragma unroll
          for (int ai = 0; ai < 2; ++ai)
#pragma unroll
              for (int m = 0; m < 4; ++m) { const float* xr = xin + (size_t)(row0 + ai * 128 + m * 16) * DD + col0;
                  f32x4 xv[2][2];
#pragma unroll
                  for (int bj = 0; bj < 2; ++bj)
#pragma unroll
                      for (int n = 0; n < 2; ++n) xv[bj][n] = *(const f32x4*)(xr + bj * 128 + 4 * n);
                  float sm = 0.f, sq = 0.f;
#pragma unroll
                  for (int bj = 0; bj < 2; ++bj)
#pragma unroll
                      for (int n = 0; n < 2; ++n) { const f32x4 y = DN_ALPHA * xv[bj][n] + gv[bj][n] * acc[ai][bj][m][n]; acc[ai][bj][m][n] = y;
                          sm += (y[0] + y[1]) + (y[2] + y[3]); sq += (y[0] * y[0] + y[1] * y[1]) + (y[2] * y[2] + y[3] * y[3]); }
                  sm += __shfl_xor(sm, 16); sm += __shfl_xor(sm, 32); sq += __shfl_xor(sq, 16); sq += __shfl_xor(sq, 32);
                  if (fq == 0) P[(ai * 128 + wr * 64 + m * 16 + fr) * 4 + wc] = (f32x2){sm, sq}; } }
        __syncthreads();
        if (tid < 256) { const f32x2 a = P[tid * 4 + 0], b2 = P[tid * 4 + 1], c = P[tid * 4 + 2], d = P[tid * 4 + 3];
            const float sm = (a.x + b2.x) + (c.x + d.x), sq = (a.y + b2.y) + (c.y + d.y);
            __hip_atomic_store(xb1 + ((size_t)(u.pm * 256 + tid) * 8 + u.pn), ((unsigned long long)__float_as_uint(sq) << 32) | __float_as_uint(sm), __ATOMIC_RELAXED, __HIP_MEMORY_SCOPE_AGENT);
            asm volatile("s_waitcnt vmcnt(0)" ::: "memory");
            if (lane == 0) __hip_atomic_fetch_add(cnt1 + 64 * u.pm, 1u, __ATOMIC_RELAXED, __HIP_MEMORY_SCOPE_AGENT); }
        if (wid == 0) (void)wait_cnt(cnt1 + 64 * u.pm);
        __syncthreads();
        if (tid < 256) { float sm = 0.f, sq = 0.f;
#pragma unroll
            for (int t = 0; t < 8; ++t) { const unsigned long long w = __hip_atomic_load(xb1 + ((size_t)(u.pm * 256 + tid) * 8 + t), __ATOMIC_RELAXED, __HIP_MEMORY_SCOPE_AGENT); sm += __uint_as_float((unsigned)w); sq += __uint_as_float((unsigned)(w >> 32)); }
            const float mean = sm * (1.0f / DD), var = fmaxf(sq * (1.0f / DD) - mean * mean, 0.f);
            S[tid] = (f32x2){mean, 1.0f / sqrtf(var + LN_EPS)}; }
        __syncthreads();
        { f32x4 gl[2][2], bl[2][2], sc[2][2], sh[2][2];
#pragma unroll
          for (int bj = 0; bj < 2; ++bj)
#pragma unroll
              for (int n = 0; n < 2; ++n) { const int c = col0 + bj * 128 + 4 * n; gl[bj][n] = *(const f32x4*)(lng + c); bl[bj][n] = *(const f32x4*)(lnb + c);
                  sc[bj][n] = *(const f32x4*)(scale + (size_t)b * 3 * DD + c) + 1.0f; sh[bj][n] = *(const f32x4*)(shift + (size_t)b * 3 * DD + c); }
#pragma unroll
          for (int ai = 0; ai < 2; ++ai)
#pragma unroll
              for (int m = 0; m < 4; ++m) { const int rl = ai * 128 + wr * 64 + m * 16 + fr; const f32x2 sr = S[rl]; bf16* xo = xout + (size_t)(u.pm * 256 + rl) * DD + col0;
                  float mx = 0.f;
#pragma unroll
                  for (int bj = 0; bj < 2; ++bj) { f32x4 xn[2];
#pragma unroll
                      for (int n = 0; n < 2; ++n) { xn[n] = (acc[ai][bj][m][n] - sr.x) * sr.y * gl[bj][n] + bl[bj][n]; const f32x4 hf = xn[n] * sc[bj][n] + sh[bj][n]; acc[ai][bj][m][n] = hf;
                          mx = fmaxf(mx, fmaxf(fmaxf(fabsf(hf[0]), fabsf(hf[1])), fmaxf(fabsf(hf[2]), fabsf(hf[3])))); }
                      u32x4 w; w.x = cvt_pk_bf16(xn[0][0], xn[0][1]); w.y = cvt_pk_bf16(xn[0][2], xn[0][3]); w.z = cvt_pk_bf16(xn[1][0], xn[1][1]); w.w = cvt_pk_bf16(xn[1][2], xn[1][3]);
                      *(u32x4*)(xo + bj * 128) = w; }
                  mx = fmaxf(mx, __shfl_xor(mx, 16)); mx = fmaxf(mx, __shfl_xor(mx, 32));
                  if (fq == 0) P[rl * 4 + wc] = (f32x2){mx, 0.f}; } }
        __syncthreads();
        if (tid < 256) { const float mx = fmaxf(fmaxf(P[tid * 4 + 0].x, P[tid * 4 + 1].x), fmaxf(P[tid * 4 + 2].x, P[tid * 4 + 3].x));
            __hip_atomic_store(xb2 + ((size_t)(u.pm * 256 + tid) * 8 + u.pn), __float_as_uint(mx), __ATOMIC_RELAXED, __HIP_MEMORY_SCOPE_AGENT);
            asm volatile("s_waitcnt vmcnt(0)" ::: "memory");
            if (lane == 0) __hip_atomic_fetch_add(cnt2 + 64 * u.pm, 1u, __ATOMIC_RELAXED, __HIP_MEMORY_SCOPE_AGENT); }
        if (wid == 0) (void)wait_cnt(cnt2 + 64 * u.pm);
        __syncthreads();
        if (tid < 256) { float amax = 0.f;
#pragma unroll
            for (int t = 0; t < 8; ++t) amax = fmaxf(amax, __uint_as_float(__hip_atomic_load(xb2 + ((size_t)(u.pm * 256 + tid) * 8 + t), __ATOMIC_RELAXED, __HIP_MEMORY_SCOPE_AGENT)));
            amax = fmaxf(amax, 1e-20f); S[tid] = (f32x2){127.0f / amax, 0.f};
            if (u.pn == 0) rs[u.pm * 256 + tid] = amax * (1.0f / 127.0f); }
        __syncthreads();
#pragma unroll
        for (int ai = 0; ai < 2; ++ai)
#pragma unroll
            for (int m = 0; m < 4; ++m) { const int rl = ai * 128 + wr * 64 + m * 16 + fr; const float q = S[rl].x; unsigned char* ho = hout + (size_t)(u.pm * 256 + rl) * DD + col0;
#pragma unroll
                for (int bj = 0; bj < 2; ++bj) { const f32x4 h0 = acc[ai][bj][m][0] * q, h1 = acc[ai][bj][m][1] * q;
                    u32x2 w; w.x = cvt_pk4_i8(h0[0], h0[1], h0[2], h0[3]); w.y = cvt_pk4_i8(h1[0], h1[1], h1[2], h1[3]); *(u32x2*)(ho + bj * 128) = w; } }
    }
};
struct EpiLnRouter {
    static constexpr bool PERM = true;
    bf16* x; unsigned char* hout;
    const float* gate; const float* lng; const float* lnb; const float* shift; const float* scale;
    const float* rw; unsigned* toke; f32x2* tokp;
    unsigned long long* xb1; unsigned long long* xb3; unsigned* cnt1; unsigned* cnt2; PG8_LAS unsigned char* lds;
    __device__ __forceinline__ bool wait_cnt(unsigned* c) const {
        bool ok = false;
        for (int it = 0; it < 400000; ++it) { if ((unsigned)__builtin_amdgcn_readfirstlane(__hip_atomic_load(c, __ATOMIC_RELAXED, __HIP_MEMORY_SCOPE_AGENT)) >= 32u) { ok = true; break; } __builtin_amdgcn_s_sleep(2); }
        return ok;
    }
    __device__ __forceinline__ void operator()(f32x4 (&acc)[2][2][4][2], const Unit& u, int wr, int wc, int fr, int fq) const {
        constexpr int DD = 2048;
        const int wid = wr * 4 + wc, lane = fr + 16 * fq, tid = wid * 64 + lane;
        PG8_LAS float* RW = (PG8_LAS float*)lds;
        PG8_LAS f32x4* L2 = (PG8_LAS f32x4*)(lds + 65536);
        PG8_LAS f32x2* P = (PG8_LAS f32x2*)(lds + 131072 + 1024);
        PG8_LAS f32x2* S = P + 1024;
        PG8_LAS f32x4* PV = (PG8_LAS f32x4*)(S + 256);
        const int b = u.pm >> 3, col0 = u.pn * 256 + wc * 32 + 8 * fq, row0 = u.pm * 256 + wr * 64 + fr;
        asm volatile("s_waitcnt vmcnt(0)" ::: "memory"); __syncthreads();
        for (int i = tid; i < DD * 8 / 4; i += 512) ((PG8_LAS f32x4*)RW)[i] = ((const f32x4*)rw)[i];
        if (tid < 64) { const int c = u.pn * 256 + 4 * tid; PV[tid] = *(const f32x4*)(lng + c); PV[64 + tid] = *(const f32x4*)(lnb + c);
            PV[128 + tid] = *(const f32x4*)(scale + (size_t)b * 3 * DD + c) + 1.0f; PV[192 + tid] = *(const f32x4*)(shift + (size_t)b * 3 * DD + c); }
        { f32x4 gv[2][2];
#pragma unroll
          for (int bj = 0; bj < 2; ++bj)
#pragma unroll
              for (int n = 0; n < 2; ++n) gv[bj][n] = *(const f32x4*)(gate + (size_t)b * 3 * DD + col0 + bj * 128 + 4 * n) + 1.0f;
#pragma unroll
          for (int ai = 0; ai < 2; ++ai)
#pragma unroll
              for (int m = 0; m < 4; ++m) { const bf16* xr = x + (size_t)(row0 + ai * 128 + m * 16) * DD + col0;
                  f32x4 xv[2][2];
#pragma unroll
                  for (int bj = 0; bj < 2; ++bj) { const u32x4 w = *(const u32x4*)(xr + bj * 128); xv[bj][0] = (f32x4){bf_lo(w.x), bf_hi(w.x), bf_lo(w.y), bf_hi(w.y)}; xv[bj][1] = (f32x4){bf_lo(w.z), bf_hi(w.z), bf_lo(w.w), bf_hi(w.w)}; }
                  float sm = 0.f, sq = 0.f;
#pragma unroll
                  for (int bj = 0; bj < 2; ++bj)
#pragma unroll
                      for (int n = 0; n < 2; ++n) { const f32x4 y = DN_ALPHA * xv[bj][n] + gv[bj][n] * acc[ai][bj][m][n]; acc[ai][bj][m][n] = y;
                          sm += (y[0] + y[1]) + (y[2] + y[3]); sq += (y[0] * y[0] + y[1] * y[1]) + (y[2] * y[2] + y[3] * y[3]); }
                  sm += __shfl_xor(sm, 16); sm += __shfl_xor(sm, 32); sq += __shfl_xor(sq, 16); sq += __shfl_xor(sq, 32);
                  if (fq == 0) P[(ai * 128 + wr * 64 + m * 16 + fr) * 4 + wc] = (f32x2){sm, sq}; } }
        __syncthreads();
        if (tid < 256) { const f32x2 a = P[tid * 4 + 0], b2 = P[tid * 4 + 1], c = P[tid * 4 + 2], d = P[tid * 4 + 3];
            const float sm = (a.x + b2.x) + (c.x + d.x), sq = (a.y + b2.y) + (c.y + d.y);
            __hip_atomic_store(xb1 + ((size_t)(u.pm * 256 + tid) * 8 + u.pn), ((unsigned long long)__float_as_uint(sq) << 32) | __float_as_uint(sm), __ATOMIC_RELAXED, __HIP_MEMORY_SCOPE_AGENT);
            asm volatile("s_waitcnt vmcnt(0)" ::: "memory");
            if (lane == 0) __hip_atomic_fetch_add(cnt1 + 64 * u.pm, 1u, __ATOMIC_RELAXED, __HIP_MEMORY_SCOPE_AGENT); }
        if (wid == 0) (void)wait_cnt(cnt1 + 64 * u.pm);
        __syncthreads();
        if (tid < 256) { float sm = 0.f, sq = 0.f;
#pragma unroll
            for (int t = 0; t < 8; ++t) { const unsigned long long w = __hip_atomic_load(xb1 + ((size_t)(u.pm * 256 + tid) * 8 + t), __ATOMIC_RELAXED, __HIP_MEMORY_SCOPE_AGENT); sm += __uint_as_float((unsigned)w); sq += __uint_as_float((unsigned)(w >> 32)); }
            const float mean = sm * (1.0f / DD), var = fmaxf(sq * (1.0f / DD) - mean * mean, 0.f);
            S[tid] = (f32x2){mean, 1.0f / sqrtf(var + LN_EPS)}; }
        __syncthreads();
#pragma unroll
        for (int ai = 0; ai < 2; ++ai)
#pragma unroll
            for (int m = 0; m < 4; ++m) { const int rl = ai * 128 + wr * 64 + m * 16 + fr; const f32x2 sr = S[rl]; const size_t ro = (size_t)(u.pm * 256 + rl) * DD + col0;
                float lg[8];
#pragma unroll
                for (int e = 0; e < 8; ++e) lg[e] = 0.f;
#pragma unroll
                for (int bj = 0; bj < 2; ++bj) { f32x4 xn[2], hf[2];
#pragma unroll
                    for (int n = 0; n < 2; ++n) { const int c4 = (wc * 32 + 8 * fq + bj * 128 + 4 * n) >> 2;
                        xn[n] = (acc[ai][bj][m][n] - sr.x) * sr.y * PV[c4] + PV[64 + c4]; hf[n] = xn[n] * PV[128 + c4] + PV[192 + c4];
#pragma unroll
                        for (int q = 0; q < 4; ++q) { const int k = col0 + bj * 128 + 4 * n + q; const f32x4 r0 = *(const PG8_LAS f32x4*)(RW + k * 8), r1 = *(const PG8_LAS f32x4*)(RW + k * 8 + 4);
                            lg[0] += hf[n][q] * r0[0]; lg[1] += hf[n][q] * r0[1]; lg[2] += hf[n][q] * r0[2]; lg[3] += hf[n][q] * r0[3]; lg[4] += hf[n][q] * r1[0]; lg[5] += hf[n][q] * r1[1]; lg[6] += hf[n][q] * r1[2]; lg[7] += hf[n][q] * r1[3]; } }
                    u32x4 w; w.x = cvt_pk_bf16(xn[0][0], xn[0][1]); w.y = cvt_pk_bf16(xn[0][2], xn[0][3]); w.z = cvt_pk_bf16(xn[1][0], xn[1][1]); w.w = cvt_pk_bf16(xn[1][2], xn[1][3]);
                    *(u32x4*)(x + ro + bj * 128) = w;
                    u32x2 hw; hw.x = cvt_pk4_fp8(hf[0][0] * F8_SA1, hf[0][1] * F8_SA1, hf[0][2] * F8_SA1, hf[0][3] * F8_SA1); hw.y = cvt_pk4_fp8(hf[1][0] * F8_SA1, hf[1][1] * F8_SA1, hf[1][2] * F8_SA1, hf[1][3] * F8_SA1);
                    *(u32x2*)(hout + ro + bj * 128) = hw; }
#pragma unroll
                for (int e = 0; e < 8; ++e) { lg[e] += __shfl_xor(lg[e], 16); lg[e] += __shfl_xor(lg[e], 32); }
                if (fq == 0) { L2[(rl * 4 + wc) * 2] = (f32x4){lg[0], lg[1], lg[2], lg[3]}; L2[(rl * 4 + wc) * 2 + 1] = (f32x4){lg[4], lg[5], lg[6], lg[7]}; } }
        __syncthreads();
        if (tid < 256) { f32x4 l0 = {0.f, 0.f, 0.f, 0.f}, l1 = {0.f, 0.f, 0.f, 0.f};
#pragma unroll
            for (int w = 0; w < 4; ++w) { l0 += L2[(tid * 4 + w) * 2]; l1 += L2[(tid * 4 + w) * 2 + 1]; }
            unsigned long long* slot = xb3 + ((size_t)(u.pm * 256 + tid) * 8 + u.pn) * 4;
            __hip_atomic_store(slot + 0, ((unsigned long long)__float_as_uint(l0[1]) << 32) | __float_as_uint(l0[0]), __ATOMIC_RELAXED, __HIP_MEMORY_SCOPE_AGENT);
            __hip_atomic_store(slot + 1, ((unsigned long long)__float_as_uint(l0[3]) << 32) | __float_as_uint(l0[2]), __ATOMIC_RELAXED, __HIP_MEMORY_SCOPE_AGENT);
            __hip_atomic_store(slot + 2, ((unsigned long long)__float_as_uint(l1[1]) << 32) | __float_as_uint(l1[0]), __ATOMIC_RELAXED, __HIP_MEMORY_SCOPE_AGENT);
            __hip_atomic_store(slot + 3, ((unsigned long long)__float_as_uint(l1[3]) << 32) | __float_as_uint(l1[2]), __ATOMIC_RELAXED, __HIP_MEMORY_SCOPE_AGENT);
            asm volatile("s_waitcnt vmcnt(0)" ::: "memory");
            if (lane == 0) __hip_atomic_fetch_add(cnt2 + 64 * u.pm, 1u, __ATOMIC_RELAXED, __HIP_MEMORY_SCOPE_AGENT); }
        if (u.pn == 0) {
            if (wid == 0) (void)wait_cnt(cnt2 + 64 * u.pm);
            __syncthreads();
            if (tid < 256) { float lg[8];
#pragma unroll
                for (int e = 0; e < 8; ++e) lg[e] = 0.f;
#pragma unroll
                for (int t = 0; t < 8; ++t) { const unsigned long long* slot = xb3 + ((size_t)(u.pm * 256 + tid) * 8 + t) * 4;
#pragma unroll
                    for (int i = 0; i < 4; ++i) { const unsigned long long w = __hip_atomic_load(slot + i, __ATOMIC_RELAXED, __HIP_MEMORY_SCOPE_AGENT); lg[2 * i] += __uint_as_float((unsigned)w); lg[2 * i + 1] += __uint_as_float((unsigned)(w >> 32)); } }
                int e1 = 0; float v1 = lg[0];
#pragma unroll
                for (int e = 1; e < 8; ++e) if (lg[e] > v1) { v1 = lg[e]; e1 = e; }
                int e2 = -1; float v2 = -3.0e38f;
#pragma unroll
                for (int e = 0; e < 8; ++e) if (e != e1 && lg[e] > v2) { v2 = lg[e]; e2 = e; }
                const float ex = __expf(v2 - v1), p1 = 1.0f / (1.0f + ex), p2 = ex / (1.0f + ex); const int mrow = u.pm * 256 + tid;
                toke[mrow] = (unsigned)e1 | ((unsigned)e2 << 8); tokp[mrow] = (f32x2){p1, p2}; }
        }
    }
};
struct EpiPool {
    static constexpr bool PERM = true;
    bf16* O; int ldc; int ocol0; const float* bias; const float* scale;
    __device__ __forceinline__ void operator()(const f32x4 (&acc)[2][2][4][2], const Unit& u, int wr, int wc, int fr, int fq) const {
        const int row0 = u.pm * BM + wr * 64 + fr, pc0 = u.pn * BM + wc * 32 + 8 * fq;
        f32x4 bv[2][2], sv[2][2];
#pragma unroll
        for (int bj = 0; bj < 2; ++bj) { bv[bj][0] = *(const f32x4*)(bias + pc0 + bj * HALF); bv[bj][1] = *(const f32x4*)(bias + pc0 + bj * HALF + 4); sv[bj][0] = *(const f32x4*)(scale + pc0 + bj * HALF); sv[bj][1] = *(const f32x4*)(scale + pc0 + bj * HALF + 4); }
#pragma unroll
        for (int ai = 0; ai < 2; ++ai)
#pragma unroll
            for (int m = 0; m < 4; ++m) { bf16* rowp = O + (size_t)(row0 + ai * HALF + m * 16) * ldc + ocol0 + pc0;
#pragma unroll
                for (int bj = 0; bj < 2; ++bj) {
                    const f32x4 v0 = (acc[ai][bj][m][0] + bv[bj][0]) * sv[bj][0], v1 = (acc[ai][bj][m][1] + bv[bj][1]) * sv[bj][1];
                    u32x4 w; w.x = cvt_pk_bf16(v0[0], v0[1]); w.y = cvt_pk_bf16(v0[2], v0[3]); w.z = cvt_pk_bf16(v1[0], v1[1]); w.w = cvt_pk_bf16(v1[2], v1[3]);
                    *(u32x4*)(rowp + bj * HALF) = w; } }
    }
};

__device__ __forceinline__ const char* uniform_ptr(const char* p) {
    const unsigned long long v = (unsigned long long)p; const unsigned lo = __builtin_amdgcn_readfirstlane((unsigned)v), hi = __builtin_amdgcn_readfirstlane((unsigned)(v >> 32));
    return (const char*)(((unsigned long long)hi << 32) | lo); }
template <class Epi, class Sched, int DT = 0, bool ALIGN_EPI = true>
__device__ __forceinline__ void gemm_phase(PG8_LAS unsigned char* lds, const Gemm g, const Sched& S, const Epi& E, int wave_in) {
    int wid = wave_in; asm volatile("" : "+s"(wid));
    const int lane = lane_id_fresh();
    const int tid = wid * 64 + lane, wr = wid >> 2, wc = wid & 3, fr = lane & 15, fq = lane >> 4;
    constexpr bool FP8 = (DT == 1);
    constexpr bool BT = (DT != 0);
    const int K = g.K, nt = K / BK;
    unsigned voffA[2], voffB[2];
#pragma unroll
    for (int i = 0; i < 2; ++i) { int R, C; stage_rc(tid * 16 + i * 8192, R, C); const int Rb = Epi::PERM ? ((R & ~31) + perm32(R & 31)) : R;
        voffA[i] = (unsigned)(R * g.lda + C) * 2u; voffB[i] = BT ? (unsigned)(tid * 16 + i * 8192) : (unsigned)(Rb * g.ldb + C) * 2u; }
    const size_t kstep = (size_t)(BK * 2), kstepB = BT ? (size_t)(2 * HTB) : kstep;
    const size_t hstepA = (size_t)HALF * g.lda * 2, hstepB = BT ? (size_t)HTB : (size_t)HALF * g.ldb * 2;
    const unsigned ldsw = (unsigned)wid * 1024u;
    const unsigned ldsb = (unsigned)(size_t)lds + ldsw;
    const int aoff = lds_byte(wr * 64 + fr, fq * 8), boff = lds_byte(wc * 32 + fr, fq * 8);
#define PG8_SA(b, h) (((b) * 2 + (h)) * HTB)
#define PG8_SB(b, h) ((4 + (b) * 2 + (h)) * HTB)
#define PG8_STAGE(bufoff, gbase, voff) do { const char* _gb = uniform_ptr((const char*)(gbase)); _Pragma("unroll") for (int _i = 0; _i < 2; ++_i) { \
        unsigned _keep; asm volatile("s_nop 4\n\ts_mov_b32 %0, m0\n\ts_mov_b32 m0, %3\n\ts_nop 0\n\tglobal_load_lds_dwordx4 %1, %2\n\ts_mov_b32 m0, %0" : "=&s"(_keep) : "v"((voff)[_i]), "s"(_gb), "s"(ldsb + (unsigned)((bufoff) + _i * 8192)) : "memory"); } } while (0)
#define PG8_LDA(dst, b, h) do { if constexpr (FP8) { _Pragma("unroll") for (int m = 0; m < 4; ++m) dst##8[m] = __builtin_shufflevector(*(const PG8_LAS i32x4v*)(lds + PG8_SA(b, h) + aoff + m * 2048), *(const PG8_LAS i32x4v*)(lds + PG8_SA(b, h) + aoff + m * 2048 + 1024), 0, 1, 2, 3, 4, 5, 6, 7); } \
        else { _Pragma("unroll") for (int m = 0; m < 4; ++m) _Pragma("unroll") for (int k = 0; k < 2; ++k) dst[m][k] = *(const PG8_LAS bf16x8*)(lds + PG8_SA(b, h) + aoff + m * 2048 + k * 1024); } } while (0)
#define PG8_LDB(dst, b, h) do { if constexpr (FP8) { _Pragma("unroll") for (int n = 0; n < 2; ++n) dst##8[n] = __builtin_shufflevector(*(const PG8_LAS i32x4v*)(lds + PG8_SB(b, h) + boff + n * 2048), *(const PG8_LAS i32x4v*)(lds + PG8_SB(b, h) + boff + n * 2048 + 1024), 0, 1, 2, 3, 4, 5, 6, 7); } \
        else { _Pragma("unroll") for (int n = 0; n < 2; ++n) _Pragma("unroll") for (int k = 0; k < 2; ++k) dst[n][k] = *(const PG8_LAS bf16x8*)(lds + PG8_SB(b, h) + boff + n * 2048 + k * 1024); } } while (0)
#define PG8_CAT(x0, x1) __builtin_shufflevector(__builtin_bit_cast(i32x4v, x0), __builtin_bit_cast(i32x4v, x1), 0, 1, 2, 3, 4, 5, 6, 7)
#define PG8_MMA(ai, bj, At, Bt) do { __builtin_amdgcn_s_setprio(1); \
        if constexpr (FP8) { _Pragma("unroll") for (int m = 0; m < 4; ++m) _Pragma("unroll") for (int n = 0; n < 2; ++n) \
            acc[ai][bj][m][n] = __builtin_amdgcn_mfma_scale_f32_16x16x128_f8f6f4(Bt##8[n], At##8[m], acc[ai][bj][m][n], 0, 0, 0, 0x7F7F7F7F, 0, 0x7F7F7F7F); } \
        else if constexpr (DT == 2) { _Pragma("unroll") for (int m = 0; m < 4; ++m) _Pragma("unroll") for (int n = 0; n < 2; ++n) _Pragma("unroll") for (int k = 0; k < 2; ++k) \
            acc[ai][bj][m][n] = __builtin_bit_cast(f32x4, __builtin_amdgcn_mfma_i32_16x16x64_i8(__builtin_bit_cast(i32x4v, Bt[n][k]), __builtin_bit_cast(i32x4v, At[m][k]), __builtin_bit_cast(i32x4v, acc[ai][bj][m][n]), 0, 0, 0)); } \
        else { _Pragma("unroll") for (int m = 0; m < 4; ++m) _Pragma("unroll") for (int n = 0; n < 2; ++n) _Pragma("unroll") for (int k = 0; k < 2; ++k) \
            acc[ai][bj][m][n] = __builtin_amdgcn_mfma_f32_16x16x32_bf16(Bt[n][k], At[m][k], acc[ai][bj][m][n], 0, 0, 0); } \
        __builtin_amdgcn_s_setprio(0); } while (0)
#define PG8_WAIT_V(n) asm volatile("s_waitcnt vmcnt(" #n ")" ::: "memory")
#define PG8_WAIT_L(n) asm volatile("s_waitcnt lgkmcnt(" #n ")" ::: "memory")
#define PG8_BAR __builtin_amdgcn_s_barrier()
#define PG8_SCHED __builtin_amdgcn_sched_barrier(0)
    Unit cur, nxt; int ui = 0;
    if (!S.next(0, cur)) return;
    f32x4 acc[2][2][4][2];
#pragma unroll
    for (int a = 0; a < 2; ++a)
#pragma unroll
        for (int b = 0; b < 2; ++b)
#pragma unroll
            for (int m = 0; m < 4; ++m)
#pragma unroll
                for (int n = 0; n < 2; ++n) acc[a][b][m][n] = (f32x4){0.f, 0.f, 0.f, 0.f};
    bf16x8 At[4][2], B0[2][2], B1[2][2]; i32x8v At8[4], B08[2], B18[2];
    (void)At; (void)B0; (void)B1; (void)At8; (void)B08; (void)B18;
    const char* cA = S.a_base(cur); const char* cB = S.b_base(cur);
    S.a_ready(cur);
    PG8_STAGE(PG8_SB(0, 0), cB, voffB); PG8_STAGE(PG8_SB(0, 1), cB + hstepB, voffB); PG8_STAGE(PG8_SA(0, 0), cA, voffA); PG8_STAGE(PG8_SA(0, 1), cA + hstepA, voffA);
    if (wr == 1) PG8_BAR;
    PG8_WAIT_V(2); PG8_BAR;
    PG8_STAGE(PG8_SB(1, 0), cB + kstepB, voffB); PG8_STAGE(PG8_SA(1, 0), cA + kstep, voffA); PG8_STAGE(PG8_SB(1, 1), cB + hstepB + kstepB, voffB);
    PG8_WAIT_V(6); PG8_BAR;
    for (;;) {
        const bool has_next = S.next(ui + 1, nxt);
        const char* nA = has_next ? S.a_base(nxt) : cA; const char* nB = has_next ? S.b_base(nxt) : cB;
        for (int t = 0; t < nt; t += 2) {
            const bool last = (t == nt - 2);
            const char* a1 = cA + (size_t)(t + 1) * kstep;
            const char* a2 = last ? nA : cA + (size_t)(t + 2) * kstep; const char* b2 = last ? nB : cB + (size_t)(t + 2) * kstepB;
            const char* a3 = a2 + kstep; const char* b3 = b2 + kstepB;
            if (last && has_next) S.a_ready(nxt);
            PG8_LDB(B0, 0, 0); PG8_LDB(B1, 0, 1); PG8_SCHED; PG8_LDA(At, 0, 0); PG8_STAGE(PG8_SA(1, 1), a1 + hstepA, voffA);
            PG8_WAIT_V(8); PG8_WAIT_L(0); PG8_BAR; PG8_MMA(0, 0, At, B0); PG8_MMA(0, 1, At, B1); PG8_BAR; PG8_SCHED;
            PG8_LDA(At, 0, 1); PG8_STAGE(PG8_SB(0, 0), b2, voffB); PG8_STAGE(PG8_SB(0, 1), b2 + hstepB, voffB); PG8_STAGE(PG8_SA(0, 0), a2, voffA);
            PG8_WAIT_V(8); PG8_WAIT_L(0); PG8_BAR; PG8_MMA(1, 0, At, B0); PG8_MMA(1, 1, At, B1); PG8_BAR; PG8_SCHED;
            PG8_LDB(B0, 1, 0); PG8_LDB(B1, 1, 1); PG8_SCHED; PG8_LDA(At, 1, 0); PG8_STAGE(PG8_SA(0, 1), a2 + hstepA, voffA);
            PG8_WAIT_V(8); PG8_WAIT_L(0); PG8_BAR; PG8_MMA(0, 0, At, B0); PG8_MMA(0, 1, At, B1); PG8_BAR; PG8_SCHED;
            PG8_LDA(At, 1, 1); PG8_STAGE(PG8_SB(1, 0), b3, voffB); PG8_STAGE(PG8_SB(1, 1), b3 + hstepB, voffB); PG8_STAGE(PG8_SA(1, 0), a3, voffA);
            PG8_WAIT_V(8); PG8_WAIT_L(0); PG8_BAR; PG8_MMA(1, 0, At, B0); PG8_MMA(1, 1, At, B1); PG8_BAR; PG8_SCHED;
        }
        if constexpr (ALIGN_EPI) { if (wr == 0) PG8_BAR; }
        { const int l2 = lane_id_fresh(); E(acc, cur, wr, wc, l2 & 15, l2 >> 4); } S.done(cur);
        if (!has_next) break;
#pragma unroll
        for (int a = 0; a < 2; ++a)
#pragma unroll
            for (int b = 0; b < 2; ++b)
#pragma unroll
                for (int m = 0; m < 4; ++m)
#pragma unroll
                    for (int n = 0; n < 2; ++n) acc[a][b][m][n] = (f32x4){0.f, 0.f, 0.f, 0.f};
        cur = nxt; cA = nA; cB = nB; ++ui;
        if constexpr (ALIGN_EPI) { if (wr == 1) PG8_BAR; }
    }
    PG8_WAIT_V(0);
    if constexpr (!ALIGN_EPI) { if (wr == 0) PG8_BAR; }
    PG8_BAR;
#undef PG8_SA
#undef PG8_SB
#undef PG8_STAGE
#undef PG8_LDA
#undef PG8_LDB
#undef PG8_MMA
#undef PG8_CAT
#undef PG8_WAIT_V
#undef PG8_WAIT_L
#undef PG8_BAR
#undef PG8_SCHED
}
}

constexpr size_t MiB = 1u << 20;
constexpr size_t WS_CTL = 0, CTL_ZERO_BYTES = 64 * 1024;
constexpr size_t WS_MOD = 1 * MiB;
constexpr size_t WS_SP = 1 * MiB + 512 * 1024;
constexpr size_t WS_META = 2 * MiB;
constexpr size_t META_TOKE = 0, META_TOKP = 64 * 1024, META_POS = 192 * 1024, META_INTS = 320 * 1024;
constexpr size_t WS_WIN = 4 * MiB;
constexpr size_t WS_WOUT = WS_WIN + 24 * MiB;
constexpr size_t WS_WG = WS_WOUT + 16 * MiB;
constexpr size_t WS_WP = WS_WG + 2 * MiB;
constexpr size_t WS_WGU = WS_WP + 1 * MiB;
constexpr size_t WS_WD = WS_WGU + 44 * MiB;
constexpr size_t WS_WEGU = WS_WD + 22 * MiB;
constexpr size_t WS_WED = WS_WEGU + 448 * MiB;
constexpr size_t WS_X = WS_WED + 224 * MiB;
constexpr size_t WS_H = WS_X + 64 * MiB;
constexpr size_t WS_O = WS_H + 32 * MiB;
constexpr size_t WS_R = WS_O + 64 * MiB;
constexpr size_t WS_Z = WS_R;
constexpr size_t WS_XC = WS_Z + 48 * MiB;
constexpr size_t WS_PP = WS_XC + 16 * MiB;
constexpr size_t WS_A = WS_PP + 16 * MiB;
constexpr size_t WS_U = WS_A + 32 * MiB;
constexpr size_t WS_YCAT = WS_U + 32 * MiB;
constexpr size_t WS_HID = WS_R;
constexpr size_t WS_HS = WS_R;
constexpr size_t WS_HIDS = WS_HS + 72 * MiB;
constexpr size_t WS_YBUF = WS_HIDS + 252 * MiB;
constexpr size_t WS_SLAB = WS_YBUF + 144 * MiB;
constexpr size_t SLAB_ELEMS = (size_t)2048 * 2048;
constexpr size_t WS_END = WS_SLAB + 64 * MiB;
static_assert(WS_YCAT + 32 * MiB <= WS_END && WS_HID + 88 * MiB <= WS_END, "overlay");
constexpr int CW_AMAX = 512;
constexpr size_t META_RS = 512 * 1024;
constexpr int CW_LNC = 8192;
constexpr int CW_BAR = 1024;

constexpr int RING_BYTES = 131072;
constexpr int LDSCTL_OFF = RING_BYTES;
constexpr int LDS_BYTES = 147456;

#define XB_TMO      128
#define XB_XCNT(j)  (256  + 64 * (j))
#define XB_XSUB(j)  (1280 + 64 * (j))
#define XB_XGEN(j)  (2304 + 64 * (j))
#define XB_TOP      3328
#define XB_TOPGEN   3392
#define XCD_BAR_WORDS 3456
#define XB_SPIN_CAP (1u << 18)
static_assert((CW_BAR + XCD_BAR_WORDS) * 4 <= (int)CTL_ZERO_BYTES, "barrier words inside the memset region");

__device__ __forceinline__ unsigned xb_ld(unsigned* p)              { return __hip_atomic_load(p, __ATOMIC_RELAXED, __HIP_MEMORY_SCOPE_AGENT); }
__device__ __forceinline__ unsigned xb_add(unsigned* p, unsigned v) { return __hip_atomic_fetch_add(p, v, __ATOMIC_RELAXED, __HIP_MEMORY_SCOPE_AGENT); }
__device__ __forceinline__ unsigned xb_xcc_id() { return (unsigned)__builtin_amdgcn_s_getreg((3 << 11) | 20) & 0xFu; }
#define XB_SPIN(cond, bar) do { unsigned _sp = 0; while (cond) { __builtin_amdgcn_s_sleep(1); \
    if ((++_sp & 255u) == 0u) { if (xb_ld(&(bar)[XB_TMO])) break; if (_sp > XB_SPIN_CAP) { atomicAdd(&(bar)[XB_TMO], 1u); break; } } } } while (0)

struct XcdBarrier { unsigned* bar; unsigned x; volatile LAS unsigned* st; };

__device__ __forceinline__ XcdBarrier xcd_barrier_post(unsigned* bar, volatile LAS unsigned* st) {
    XcdBarrier b; b.bar = bar; b.x = xb_xcc_id(); b.st = st;
    if (threadIdx.x == 0) (void)xb_add(&bar[XB_XCNT(b.x)], 1u);
    return b;
}
__device__ __forceinline__ bool xb_is_thread0(int wave) { return wave == 0 && lane_id_fresh() == 0; }
__device__ __forceinline__ void xcd_barrier_complete(unsigned* bar, unsigned x, unsigned& nloc, unsigned& nx) {
    const unsigned G = gridDim.x * gridDim.y * gridDim.z;
    unsigned sum, cnt, mine, sp = 0u;
    for (;;) {
        sum = 0u; cnt = 0u; mine = 0u;
#pragma unroll
        for (unsigned j = 0; j < 16; ++j) { const unsigned c = xb_ld(&bar[XB_XCNT(j)]); sum += c; cnt += (c > 0u) ? 1u : 0u; mine = (j == x) ? c : mine; }
        if (sum == G) break;
        __builtin_amdgcn_s_sleep(1);
        if ((++sp & 255u) == 0u) { if (xb_ld(&bar[XB_TMO])) break; if (sp > XB_SPIN_CAP) { atomicAdd(&bar[XB_TMO], 1u); break; } }
    }
    nloc = mine > 0u ? mine : 1u; nx = cnt > 0u ? cnt : 1u;
}
__device__ __forceinline__ void xcd_barrier(const XcdBarrier& b, int wave) {
    asm volatile("s_waitcnt vmcnt(0)" ::: "memory");
    __syncthreads();
    if (xb_is_thread0(wave)) {
        unsigned* bar = b.bar;
        __builtin_amdgcn_s_waitcnt(0);
        unsigned nloc = b.st[0], nx = b.st[1];
        if (nloc == 0u) { xcd_barrier_complete(bar, b.x, nloc, nx); b.st[0] = nloc; b.st[1] = nx; }
        const unsigned old = xb_add(&bar[XB_XSUB(b.x)], 1u);
        const unsigned gen = old / nloc;
        if (old + 1u == (gen + 1u) * nloc) {
            __builtin_amdgcn_fence(__ATOMIC_RELEASE, "agent");
            asm volatile("s_waitcnt vmcnt(0)" ::: "memory");
            const unsigned og = xb_add(&bar[XB_TOP], 1u);
            const unsigned tg = og / nx;
            if (og + 1u == (tg + 1u) * nx) xb_add(&bar[XB_TOPGEN], 1u);
            else XB_SPIN(xb_ld(&bar[XB_TOPGEN]) == tg, bar);
            __builtin_amdgcn_fence(__ATOMIC_ACQUIRE, "agent");
            xb_add(&bar[XB_XGEN(b.x)], 1u);
            asm volatile("s_waitcnt vmcnt(0)" ::: "memory");
        } else {
            XB_SPIN(xb_ld(&bar[XB_XGEN(b.x)]) == gen, bar);
            __builtin_amdgcn_fence(__ATOMIC_ACQUIRE, "agent");
            asm volatile("s_waitcnt vmcnt(0)" ::: "memory");
        }
    }
    __syncthreads();
}

#define LDS_WAIT() asm volatile("s_waitcnt lgkmcnt(0)" ::: "memory")
__device__ __forceinline__ float wave_sum(float v) {
#pragma unroll
    for (int o = 1; o < 64; o <<= 1) v += __shfl_xor(v, o);
    return v;
}

struct TItem { const float* src; unsigned char* dst; int N, ldb, f8; float scale; };
__device__ __forceinline__ void titem_load(const TItem& t, f32x4 (&v)[8], int lane) {
    const float* p = t.src + (size_t)(8 * (lane >> 3)) * t.N + 4 * (lane & 7);
#pragma unroll
    for (int i = 0; i < 8; ++i) v[i] = __builtin_nontemporal_load((const f32x4*)(p + (size_t)i * t.N));
}
__device__ __forceinline__ void titem_store(const TItem& t, const f32x4 (&v)[8], LAS float* scr, int lane) {
    (void)scr;
    {
        unsigned char* d = t.dst + (size_t)(4 * (lane & 7)) * t.ldb + 16 * (lane >> 3);
#pragma unroll
        for (int q = 0; q < 4; ++q) { u32x4 o; o.x = cvt_pk_bf16(v[0][q], v[1][q]); o.y = cvt_pk_bf16(v[2][q], v[3][q]); o.z = cvt_pk_bf16(v[4][q], v[5][q]); o.w = cvt_pk_bf16(v[6][q], v[7][q]);
            *(u32x4*)(d + (size_t)q * t.ldb) = o; }
    }
}

struct Args { const float* in[25]; float* out; unsigned char* ws; int ph_lo, ph_hi; };
enum { IN_X = 0, IN_C, IN_ADAW, IN_ADAB, IN_LNG, IN_LNB, IN_WIN, IN_CONVW, IN_CONVB, IN_WA, IN_BA, IN_WX, IN_BX, IN_LAM, IN_POOLW, IN_POOLB, IN_POOLS, IN_WOUT,
       IN_FG, IN_FU, IN_FD, IN_ROUTER, IN_EG, IN_EU, IN_ED };

constexpr int I_IN = 32 * 48, I_OUT = 32 * 64, I_SM = 32, I_FG = 32 * 88, I_FD = 88 * 32, I_EG = 32 * 112, I_ED = 112 * 32;
constexpr int T_OUT = 0, T_LRU = T_OUT + 2 * I_OUT, T_POOL = T_LRU + 16 * I_SM, T_FD = T_POOL + 8 * I_SM, T_IN = T_FD + I_FD, T_FG = T_IN + 2 * I_IN, T_ED = T_FG + 2 * I_FG, T_EG = T_ED + 8 * I_ED, T_END = T_EG + 16 * I_EG;

#ifndef CV_P2_WGS
#define CV_P2_WGS 128
#endif
#ifndef CV_P8_WGS
#define CV_P8_WGS 141
#endif
#ifndef CV_N_P2
#define CV_N_P2 19000
#endif
#ifndef CV_N_P8
#define CV_N_P8 53000
#endif
constexpr int CV_A0 = T_FG, CV_A1 = CV_A0 + CV_N_P2, CV_B1 = CV_A1 + CV_N_P8, CV_C1 = CV_B1 + CV_N_P2;
static_assert(CV_C1 <= T_END, "conversion chunks");
__device__ __forceinline__ bool titem_decode(const Args& args, unsigned char* ws, int it, int it_end, TItem& t) {
    if (it >= it_end) return false;
    const float* src; bf16* dst; int N, ldt, nblk, rowbase, mode, r, f8 = 0; float scale = 1.0f;
    if (it < T_LRU) { r = it - T_OUT; const int l = r / I_OUT; r -= l * I_OUT; src = args.in[IN_WOUT] + (size_t)l * D * D; N = D; nblk = D / 32; dst = (bf16*)(ws + WS_WOUT) + (size_t)l * D * D; ldt = D; rowbase = 0; mode = 0; }
    else if (it < T_POOL) { r = it - T_LRU; const int q = r / I_SM; r -= q * I_SM; const int l = q >> 3, ax = (q >> 2) & 1, h = q & 3;
        src = args.in[ax ? IN_WX : IN_WA] + (size_t)(l * 4 + h) * 65536; N = 256; nblk = 8; dst = (bf16*)(ws + WS_WG) + (size_t)l * 2048 * 256; ldt = 256; rowbase = h * 512 + ax * 128; mode = 1; }
    else if (it < T_FD) { r = it - T_POOL; const int q = r / I_SM; r -= q * I_SM; const int l = q >> 2, gq = q & 3;
        src = args.in[IN_POOLW] + (size_t)(l * 4 + gq) * 65536; N = 256; nblk = 8; dst = (bf16*)(ws + WS_WP) + (size_t)l * 1024 * 256; ldt = 256; rowbase = gq * 256; mode = 0; }
    else if (it < T_IN) { r = it - T_FD; src = args.in[IN_FD]; N = D; nblk = D / 64; dst = (bf16*)(ws + WS_WD); ldt = DFF / 128; rowbase = 0; mode = 0; f8 = 1; scale = F8_SB2; }
    else if (it < T_FG) { r = it - T_IN; const int l = r / I_IN; r -= l * I_IN; src = args.in[IN_WIN] + (size_t)l * D * DIN; N = DIN; nblk = DIN / 64; dst = (bf16*)(ws + WS_WIN + (size_t)l * DIN * D); ldt = D / 128; rowbase = 0; mode = 0; f8 = 2;
        scale = 127.0f / __uint_as_float(*((const unsigned*)(ws + WS_CTL) + CW_AMAX + 1 + l)); }
    else if (it < T_ED) { r = it - T_FG; const int gu = r / I_FG; r -= gu * I_FG; src = args.in[gu ? IN_FU : IN_FG]; N = DFF; nblk = DFF / 64; dst = (bf16*)(ws + WS_WGU); ldt = D / 128; rowbase = gu * 128; mode = 1; f8 = 2;
        scale = 127.0f / __uint_as_float(*((const unsigned*)(ws + WS_CTL) + CW_AMAX)); }
    else if (it < T_EG) { r = it - T_ED; const int e = r / I_ED; r -= e * I_ED; src = args.in[IN_ED] + (size_t)e * DFE * D; N = D; nblk = D / 64; dst = (bf16*)(ws + WS_WED + (size_t)e * D * DFE); ldt = DFE / 128; rowbase = 0; mode = 0; f8 = 1; scale = F8_SB2; }
    else { r = it - T_EG; const int q = r / I_EG; r -= q * I_EG; const int e = q >> 1, gu = q & 1;
        src = args.in[gu ? IN_EU : IN_EG] + (size_t)e * D * DFE; N = DFE; nblk = DFE / 64; dst = (bf16*)(ws + WS_WEGU + (size_t)e * 2 * DFE * D); ldt = D / 128; rowbase = gu * 128; mode = 1; f8 = 1; scale = F8_SB1; }
    const int kb = r / nblk, nb = r - kb * nblk, n0 = (f8 ? 64 : 32) * nb, k0 = 64 * kb;
    const int drow0 = mode ? rowbase + (n0 >> 7) * 256 + (n0 & 127) : rowbase + n0;
    t.src = src + (size_t)k0 * N + n0; t.N = N; t.f8 = f8; t.scale = scale;
    if (f8) { t.dst = (unsigned char*)dst + (size_t)(((drow0 >> 8) * ldt + (k0 >> 7)) * 2 + ((drow0 >> 7) & 1)) * 16384 + (2 * ((drow0 & 127) >> 4) + ((k0 >> 6) & 1)) * 1024; t.ldb = 0; }
    else { t.dst = (unsigned char*)dst + ((size_t)drow0 * ldt + k0) * 2; t.ldb = ldt * 2; }
    return true;
}
__device__ __forceinline__ void titem_load16(const TItem& t, f32x4 (&v)[16], int lane) {
    const float* p = t.src + (size_t)(16 * (lane >> 4)) * t.N + 4 * (lane & 15);
#pragma unroll
    for (int i = 0; i < 16; ++i) v[i] = __builtin_nontemporal_load((const f32x4*)(p + (size_t)i * t.N));
}
__device__ __forceinline__ void titem_store16(const TItem& t, const f32x4 (&v)[16], int lane) {
    const int g = lane >> 4, c = lane & 15, cp = c & 7, Rl = 32 * (c >> 3) + 16 * (cp & 1) + 4 * (cp >> 1), rr0 = Rl & 15;
    unsigned char* d = t.dst + (Rl >> 4) * 2048 + rr0 * 64 + ((16 * g) ^ (rr0 >= 8 ? 32 : 0)); const float sc = t.scale;
    if (t.f8 == 2) {
#pragma unroll
        for (int q = 0; q < 4; ++q) { u32x4 o; o.x = cvt_pk4_i8(v[0][q] * sc, v[1][q] * sc, v[2][q] * sc, v[3][q] * sc); o.y = cvt_pk4_i8(v[4][q] * sc, v[5][q] * sc, v[6][q] * sc, v[7][q] * sc);
            o.z = cvt_pk4_i8(v[8][q] * sc, v[9][q] * sc, v[10][q] * sc, v[11][q] * sc); o.w = cvt_pk4_i8(v[12][q] * sc, v[13][q] * sc, v[14][q] * sc, v[15][q] * sc); *(u32x4*)(d + 64 * q) = o; }
    } else {
#pragma unroll
        for (int q = 0; q < 4; ++q) { u32x4 o; o.x = cvt_pk4_fp8(v[0][q] * sc, v[1][q] * sc, v[2][q] * sc, v[3][q] * sc); o.y = cvt_pk4_fp8(v[4][q] * sc, v[5][q] * sc, v[6][q] * sc, v[7][q] * sc);
            o.z = cvt_pk4_fp8(v[8][q] * sc, v[9][q] * sc, v[10][q] * sc, v[11][q] * sc); o.w = cvt_pk4_fp8(v[12][q] * sc, v[13][q] * sc, v[14][q] * sc, v[15][q] * sc); *(u32x4*)(d + 64 * q) = o; }
    }
}
__device__ __forceinline__ void convert_items_bf16(const Args& args, unsigned char* ws, LAS unsigned char* lds, int it0, int it_end, int w, int nw, int wave, int lane) {
    LAS float* scr = (LAS float*)(lds + wave * 16384);
    TItem t0, t1, t2, t3; f32x4 v0[8], v1[8], v2[8], v3[8];
    int it = it0 + w;
    bool h0 = titem_decode(args, ws, it, it_end, t0), h1, h2, h3; if (h0) titem_load(t0, v0, lane); it += nw;
    h1 = titem_decode(args, ws, it, it_end, t1); if (h1) titem_load(t1, v1, lane); it += nw;
    h2 = titem_decode(args, ws, it, it_end, t2); if (h2) titem_load(t2, v2, lane); it += nw;
    for (;;) {
        if (!h0) break; h3 = titem_decode(args, ws, it, it_end, t3); if (h3) titem_load(t3, v3, lane); it += nw; titem_store(t0, v0, scr, lane);
        if (!h1) break; h0 = titem_decode(args, ws, it, it_end, t0); if (h0) titem_load(t0, v0, lane); it += nw; titem_store(t1, v1, scr, lane);
        if (!h2) break; h1 = titem_decode(args, ws, it, it_end, t1); if (h1) titem_load(t1, v1, lane); it += nw; titem_store(t2, v2, scr, lane);
        if (!h3) break; h2 = titem_decode(args, ws, it, it_end, t2); if (h2) titem_load(t2, v2, lane); it += nw; titem_store(t3, v3, scr, lane);
    }
}
__device__ __forceinline__ void convert_items(const Args& args, unsigned char* ws, LAS unsigned char* lds, int it0, int it_end, int w, int nw, int wave, int lane) {
    (void)lds; (void)wave;
    TItem t0, t1; f32x4 v0[16], v1[16];
    int it = it0 + w;
    bool h0 = titem_decode(args, ws, it, it_end, t0), h1; if (h0) titem_load16(t0, v0, lane); it += nw;
    for (;;) {
        if (!h0) break; h1 = titem_decode(args, ws, it, it_end, t1); if (h1) titem_load16(t1, v1, lane); it += nw; titem_store16(t0, v0, lane);
        if (!h1) break; h0 = titem_decode(args, ws, it, it_end, t0); if (h0) titem_load16(t0, v0, lane); it += nw; titem_store16(t1, v1, lane);
    }
}

__device__ __forceinline__ float absmax_span(const float* w, int n4, int gw, int NGW, int lane) {
    float mx = 0.f;
#pragma unroll 1
    for (int i0 = gw * 64 + lane; i0 < n4; i0 += NGW * 64 * 8) { f32x4 a[8];
#pragma unroll
        for (int q = 0; q < 8; ++q) { const int i = i0 + q * NGW * 64; a[q] = (i < n4) ? __builtin_nontemporal_load((const f32x4*)w + i) : (f32x4){0.f, 0.f, 0.f, 0.f}; }
#pragma unroll
        for (int q = 0; q < 8; ++q) mx = fmaxf(mx, fmaxf(fmaxf(fabsf(a[q][0]), fabsf(a[q][1])), fmaxf(fabsf(a[q][2]), fabsf(a[q][3])))); }
#pragma unroll
    for (int o = 1; o < 64; o <<= 1) mx = fmaxf(mx, __shfl_xor(mx, o));
    return mx;
}
__device__ __forceinline__ void p0_absmax(const Args& args, unsigned* amax_bits, LAS unsigned char* lds, int gw, int NGW, int tid, int lane) {
    const float m0 = fmaxf(absmax_span(args.in[IN_FG], D * DFF / 4, gw, NGW, lane), absmax_span(args.in[IN_FU], D * DFF / 4, gw, NGW, lane));
    const float m1 = absmax_span(args.in[IN_WIN], D * DIN / 4, gw, NGW, lane), m2 = absmax_span(args.in[IN_WIN] + (size_t)D * DIN, D * DIN / 4, gw, NGW, lane);
    LAS float* red = (LAS float*)lds;
    if (lane == 0) { red[(tid >> 6) * 3 + 0] = m0; red[(tid >> 6) * 3 + 1] = m1; red[(tid >> 6) * 3 + 2] = m2; }
    __syncthreads();
    if (tid < 3) { float m = red[tid];
#pragma unroll
        for (int w = 1; w < 8; ++w) m = fmaxf(m, red[w * 3 + tid]);
        (void)__hip_atomic_fetch_max(amax_bits + tid, __float_as_uint(m), __ATOMIC_RELAXED, __HIP_MEMORY_SCOPE_AGENT); }
}

__device__ __forceinline__ void p0_adaln(const Args& args, unsigned char* ws, LAS unsigned char* lds, int vcu, int G, int tid, int wave, int lane) {
    LAS float* cact = (LAS float*)lds;
    LAS float* red = (LAS float*)(lds + 32768);
    for (int i = tid; i < NB * D; i += 512) { const float v = args.in[IN_C][i]; cact[i] = v * fast_sigmoid(v); }
    __syncthreads();
    float* mod = (float*)(ws + WS_MOD);
    for (int item = vcu; item < 256; item += G) {
        const int ls = item >> 6, cb = item & 63;
        const int lc = lane < 48 ? lane : 47;
        const float* W = args.in[IN_ADAW] + (size_t)ls * D * 3 * D + cb * 96 + lc * 2;
        f32x2 acc[4];
#pragma unroll
        for (int b = 0; b < 4; ++b) acc[b] = (f32x2){0.f, 0.f};
        const int kbeg = wave * 256;
#pragma unroll 1
        for (int k0 = kbeg; k0 < kbeg + 256; k0 += 16) { f32x2 wv[16];
#pragma unroll
            for (int i = 0; i < 16; ++i) wv[i] = __builtin_nontemporal_load((const f32x2*)(W + (size_t)(k0 + i) * (3 * D)));
#pragma unroll
            for (int i = 0; i < 16; ++i) {
#pragma unroll
                for (int b = 0; b < 4; ++b) { const float cv = cact[b * D + k0 + i]; acc[b] += wv[i] * cv; } } }
        if (lane < 48) {
#pragma unroll
            for (int b = 0; b < 4; ++b) { red[(wave * 4 + b) * 96 + lane * 2] = acc[b].x; red[(wave * 4 + b) * 96 + lane * 2 + 1] = acc[b].y; } }
        __syncthreads();
        if (tid < 384) { const int b = tid / 96, cc = tid - b * 96; float s = args.in[IN_ADAB][ls * 3 * D + cb * 96 + cc];
#pragma unroll
          for (int w = 0; w < 8; ++w) s += red[(w * 4 + b) * 96 + cc];
          mod[(size_t)(ls * 4 + b) * 3 * D + cb * 96 + cc] = s; }
        __syncthreads();
    }
}

__device__ __forceinline__ void p1_mod_rows(const float* x, const float* mod_ls, bf16* h, float* rs, int gw, int NGW, int lane) {
    (void)NGW;
    const int mb = 4 * gw, b = mb / SEQ; const f32x4* sh = (const f32x4*)(mod_ls + (size_t)b * 3 * D) + lane;
    f32x4 xv[2][8], s0[8], s1[8];
#pragma unroll
    for (int j = 0; j < 8; ++j) { s0[j] = sh[64 * j]; s1[j] = sh[64 * j + D / 4] + 1.0f; xv[0][j] = ((const f32x4*)(x + (size_t)mb * D) + lane)[64 * j]; }
#pragma unroll
    for (int k = 0; k < 4; ++k) { const int m = mb + k;
        if (k + 1 < 4) {
#pragma unroll
            for (int j = 0; j < 8; ++j) xv[(k + 1) & 1][j] = ((const f32x4*)(x + (size_t)(m + 1) * D) + lane)[64 * j];
            __builtin_amdgcn_sched_barrier(0);
        }
        float amax = 0.f;
#pragma unroll
        for (int j = 0; j < 8; ++j) { const f32x4 o = xv[k & 1][j] * s1[j] + s0[j]; xv[k & 1][j] = o; amax = fmaxf(amax, fmaxf(fmaxf(fabsf(o[0]), fabsf(o[1])), fmaxf(fabsf(o[2]), fabsf(o[3])))); }
#pragma unroll
        for (int o = 1; o < 64; o <<= 1) amax = fmaxf(amax, __shfl_xor(amax, o));
        amax = fmaxf(amax, 1e-20f); const float q = 127.0f / amax;
        if (lane == 0) rs[m] = amax * (1.0f / 127.0f);
#pragma unroll
        for (int j = 0; j < 8; ++j) ((unsigned*)((unsigned char*)h + (size_t)m * D) + lane)[64 * j] = cvt_pk4_i8(xv[k & 1][j][0] * q, xv[k & 1][j][1] * q, xv[k & 1][j][2] * q, xv[k & 1][j][3] * q);
    }
}

__device__ __forceinline__ void p3_conv_pool(const bf16* Z, const float* convw, const float* convb, bf16* XC, bf16* PP, int vcu, int G, int tid) {
    const int c0 = 2 * tid;
    const f32x2 w0 = *(const f32x2*)(convw + c0), w1 = *(const f32x2*)(convw + 1024 + c0), w2 = *(const f32x2*)(convw + 2048 + c0), w3 = *(const f32x2*)(convw + 3072 + c0), cb = *(const f32x2*)(convb + c0);
    const int win = 2 << (tid >> 7);
    for (int item = vcu; item < NB * (SEQ / 32); item += G) {
        const int b = item / (SEQ / 32), t0 = (item - b * (SEQ / 32)) * 32;
        const bf16* zb = Z + (size_t)b * SEQ * DIN;
        unsigned cr[35], pr[47];
#pragma unroll
        for (int i = 0; i < 35; ++i) { const int t = t0 - 3 + i; cr[i] = *(const unsigned*)(zb + (size_t)(t < 0 ? 0 : t) * DIN + c0); }
#pragma unroll
        for (int i = 0; i < 47; ++i) { const int t = t0 - 15 + i; pr[i] = *(const unsigned*)(zb + (size_t)(t < 0 ? 0 : t) * DIN + 2048 + c0); }
        if (t0 == 0) {
#pragma unroll
            for (int i = 0; i < 3; ++i) cr[i] = 0u;
#pragma unroll
            for (int i = 0; i < 15; ++i) pr[i] = 0u;
        }
#pragma unroll
        for (int i = 0; i < 32; ++i) { const f32x2 xm3 = {bf_lo(cr[i]), bf_hi(cr[i])}, xm2 = {bf_lo(cr[i + 1]), bf_hi(cr[i + 1])}, xm1 = {bf_lo(cr[i + 2]), bf_hi(cr[i + 2])}, x0 = {bf_lo(cr[i + 3]), bf_hi(cr[i + 3])};
            const f32x2 y = cb + w0 * xm3 + w1 * xm2 + w2 * xm1 + w3 * x0;
            *(unsigned*)(XC + (size_t)(b * SEQ + t0 + i) * DLRU + c0) = cvt_pk_bf16(y.x, y.y); }
        f32x2 sacc = {0.f, 0.f};
#pragma unroll
        for (int i = 0; i < 15; ++i) { if (i >= 16 - win) sacc += (f32x2){bf_lo(pr[i]), bf_hi(pr[i])}; }
#pragma unroll
        for (int i = 0; i < 32; ++i) { const int t = t0 + i; const f32x2 xt = {bf_lo(pr[15 + i]), bf_hi(pr[15 + i])};
            sacc += xt; const float cnt = (float)((t + 1) < win ? (t + 1) : win);
            const f32x2 p = {sacc.x / cnt - xt.x, sacc.y / cnt - xt.y};
            *(unsigned*)(PP + (size_t)(b * SEQ + t) * DLRU + c0) = cvt_pk_bf16(p.x, p.y);
            const unsigned q2 = pr[15 + i - 1], q4 = pr[15 + i - 3], q8 = pr[15 + i - 7], q16 = pr[15 + i - 15];
            const unsigned q = win == 2 ? q2 : (win == 4 ? q4 : (win == 8 ? q8 : q16));
            sacc -= (f32x2){bf_lo(q), bf_hi(q)}; }
    }
}

__device__ __forceinline__ void conv_tile(const bf16* Z, const float* convw, const float* convb, bf16* XC, int pm, int h, int tid) {
    const int c0 = 256 * h + 4 * (tid & 63), b = pm >> 3, t0 = (pm & 7) * 256 + (tid >> 6) * 32;
    const f32x4 w0 = *(const f32x4*)(convw + c0), w1 = *(const f32x4*)(convw + 1024 + c0), w2 = *(const f32x4*)(convw + 2048 + c0), w3 = *(const f32x4*)(convw + 3072 + c0), cb = *(const f32x4*)(convb + c0);
    const bf16* zb = Z + (size_t)b * SEQ * DIN + c0;
    u32x2 cr[35];
    if (t0 == 0) {
#pragma unroll
        for (int i = 0; i < 3; ++i) cr[i] = (u32x2){0u, 0u};
#pragma unroll
        for (int i = 3; i < 35; ++i) cr[i] = *(const u32x2*)(zb + (size_t)(i - 3) * DIN);
    } else { const bf16* p0 = zb + (size_t)(t0 - 3) * DIN;
#pragma unroll
        for (int i = 0; i < 35; ++i) cr[i] = *(const u32x2*)(p0 + (size_t)i * DIN); }
    bf16* xo = XC + (size_t)(b * SEQ + t0) * DLRU + c0;
#pragma unroll
    for (int i = 0; i < 32; ++i) { const f32x4 y = cb + w0 * bf4(cr[i]) + w1 * bf4(cr[i + 1]) + w2 * bf4(cr[i + 2]) + w3 * bf4(cr[i + 3]);
        u32x2 o; o.x = cvt_pk_bf16(y[0], y[1]); o.y = cvt_pk_bf16(y[2], y[3]); *(u32x2*)(xo + (size_t)i * DLRU) = o; }
}
__device__ __forceinline__ void pool_tile(const bf16* Z, bf16* PP, int pm, int g, int tid) {
    const int c0 = 256 * g + 4 * (tid & 63), b = pm >> 3, t0 = (pm & 7) * 256 + (tid >> 6) * 32, win = 2 << g;
    const bf16* zb = Z + (size_t)b * SEQ * DIN + 2048 + c0;
    u32x2 pr[47];
    if (t0 == 0) {
#pragma unroll
        for (int i = 0; i < 15; ++i) pr[i] = (u32x2){0u, 0u};
#pragma unroll
        for (int i = 15; i < 47; ++i) pr[i] = *(const u32x2*)(zb + (size_t)(i - 15) * DIN);
    } else { const bf16* p0 = zb + (size_t)(t0 - 15) * DIN;
#pragma unroll
        for (int i = 0; i < 47; ++i) pr[i] = *(const u32x2*)(p0 + (size_t)i * DIN); }
    f32x4 sacc = {0.f, 0.f, 0.f, 0.f};
#pragma unroll
    for (int i = 0; i < 15; ++i) { if (i >= 16 - win) sacc += bf4(pr[i]); }
    bf16* po = PP + (size_t)(b * SEQ + t0) * DLRU + c0;
#pragma unroll
    for (int i = 0; i < 32; ++i) { const int t = t0 + i; const f32x4 xt = bf4(pr[15 + i]);
        sacc += xt; const float rc = __builtin_amdgcn_rcpf((float)((t + 1) < win ? (t + 1) : win));
        const f32x4 p = sacc * rc - xt;
        u32x2 o; o.x = cvt_pk_bf16(p[0], p[1]); o.y = cvt_pk_bf16(p[2], p[3]); *(u32x2*)(po + (size_t)i * DLRU) = o;
        const u32x2 q2 = pr[15 + i - 1], q4 = pr[15 + i - 3], q8 = pr[15 + i - 7], q16 = pr[15 + i - 15];
        const u32x2 q = win == 2 ? q2 : (win == 4 ? q4 : (win == 8 ? q8 : q16));
        sacc -= bf4(q); }
}

__device__ __forceinline__ void p5_scan(const unsigned* AU, const bf16* Z, bf16* YCAT, LAS unsigned char* lds, int vcu, int G, int tid) {
    LAS float* sP = (LAS float*)lds; LAS float* sH = sP + 512;
    const int c = tid & 15, seg = tid >> 4;
    for (int item = vcu; item < NB * (DLRU / 16); item += G) {
        const int b = item / (DLRU / 16), ch = (item - b * (DLRU / 16)) * 16 + c;
        const size_t row0 = (size_t)b * SEQ + seg * 64;
        const unsigned* ap = AU + row0 * DLRU + ch;
        float Ls = 0.f, H = 0.f;
#pragma unroll 1
        for (int i0 = 0; i0 < 64; i0 += 16) { unsigned wv[16];
#pragma unroll
            for (int i = 0; i < 16; ++i) wv[i] = ap[(size_t)(i0 + i) * DLRU];
#pragma unroll
            for (int i = 0; i < 16; ++i) { const float la = bf_lo(wv[i]); H = __expf(la) * H + bf_hi(wv[i]); Ls += la; } }
        sP[tid] = __expf(Ls); sH[tid] = H;
        __syncthreads();
        float h = 0.f;
        for (int s2 = 0; s2 < seg; ++s2) h = sP[s2 * 16 + c] * h + sH[s2 * 16 + c];
        const bf16* gp = Z + row0 * DIN + 1024 + ch; bf16* yp = YCAT + row0 * D + ch;
#pragma unroll 1
        for (int i0 = 0; i0 < 64; i0 += 8) { unsigned wv[8]; bf16 gv[8];
#pragma unroll
            for (int i = 0; i < 8; ++i) { wv[i] = ap[(size_t)(i0 + i) * DLRU]; gv[i] = gp[(size_t)(i0 + i) * DIN]; }
#pragma unroll
            for (int i = 0; i < 8; ++i) { h = __expf(bf_lo(wv[i])) * h + bf_hi(wv[i]); const float gz = __uint_as_float((unsigned)gv[i] << 16);
                yp[(size_t)(i0 + i) * D] = (bf16)(cvt_pk_bf16(h * gelu_tanh(gz), 0.f) & 0xffffu); } }
        __syncthreads();
    }
}

template <bool MOE_IN, bool HAS_NEXT, bool ROUTER, bool H_F8 = false, int RR = 4>
__device__ __forceinline__ void ln_phase(const float* __restrict__ xin, float* __restrict__ xout,     const bf16* O, const bf16* O2, const float* gate_mod  , const float* lng, const float* lnb,
                                         const float* next_mod, bf16* hout, const float* router_w, unsigned char* meta, LAS unsigned char* lds, int gw, int NGW, int tid, int lane) {
    LAS float* rw = (LAS float*)lds;
    if (ROUTER) { for (int i = tid; i < D * NE / 4; i += 512) ((LAS f32x4*)rw)[i] = ((const f32x4*)router_w)[i]; __syncthreads(); }
    constexpr size_t SL4 = SLAB_ELEMS / 4;
    constexpr int R = RR;
    for (int m0 = R * gw; m0 < M; m0 += R * NGW) {
        const int b = m0 / SEQ;
        const f32x4* gt = (const f32x4*)(gate_mod + (size_t)b * 3 * D + 2 * D) + lane;
        f32x4 y[R][8]; float sum[R];
#pragma unroll
        for (int r = 0; r < R; ++r) sum[r] = 0.f;
        const u32x2* yp1[R]; const u32x2* yp2[R]; f32x2 pr[R]; bool tl1[R], tl2[R];
        if (MOE_IN) {
#pragma unroll
            for (int r = 0; r < R; ++r) { const int p1 = ((const int*)(meta + META_POS))[2 * (m0 + r)], p2 = ((const int*)(meta + META_POS))[2 * (m0 + r) + 1]; pr[r] = ((const f32x2*)(meta + META_TOKP))[m0 + r];
                tl1[r] = p1 >= 2 * M; tl2[r] = p2 >= 2 * M;
                yp1[r] = tl1[r] ? (const u32x2*)(O2 + (size_t)(p1 - 2 * M) * D) + lane : (const u32x2*)(O + (size_t)p1 * D) + lane;
                yp2[r] = tl2[r] ? (const u32x2*)(O2 + (size_t)(p2 - 2 * M) * D) + lane : (const u32x2*)(O + (size_t)p2 * D) + lane; }
        }
#pragma unroll
        for (int jc = 0; jc < 4; ++jc) {
            f32x4 xv[R][2], ov[R][2], gv[2];
#pragma unroll
            for (int jj = 0; jj < 2; ++jj) { const int j = 2 * jc + jj; gv[jj] = gt[64 * j];
#pragma unroll
                for (int r = 0; r < R; ++r) { xv[r][jj] = ((const f32x4*)(xin + (size_t)(m0 + r) * D) + lane)[64 * j];
                    if (MOE_IN) { f32x4 a1 = bf4(yp1[r][64 * j]), a2 = bf4(yp2[r][64 * j]);
                        if (tl1[r]) a1 = (a1 + bf4(yp1[r][64 * j + SL4])) + (bf4(yp1[r][64 * j + 2 * SL4]) + bf4(yp1[r][64 * j + 3 * SL4]));
                        if (tl2[r]) a2 = (a2 + bf4(yp2[r][64 * j + SL4])) + (bf4(yp2[r][64 * j + 2 * SL4]) + bf4(yp2[r][64 * j + 3 * SL4]));
                        ov[r][jj] = pr[r].x * a1 + pr[r].y * a2; }
                    else ov[r][jj] = bf4(((const u32x2*)(O + (size_t)(m0 + r) * D) + lane)[64 * j]); } }
#pragma unroll
            for (int jj = 0; jj < 2; ++jj)
#pragma unroll
                for (int r = 0; r < R; ++r) { const f32x4 v = DN_ALPHA * xv[r][jj] + (1.0f + gv[jj]) * ov[r][jj]; y[r][2 * jc + jj] = v; sum[r] += (v[0] + v[1]) + (v[2] + v[3]); }
            if (ROUTER || MOE_IN) asm volatile("" ::: "memory");
        }
        float rstd[R];
#pragma unroll
        for (int r = 0; r < R; ++r) { const float mean = wave_sum(sum[r]) * (1.0f / D); float s2 = 0.f;
#pragma unroll
            for (int j = 0; j < 8; ++j) { y[r][j] = y[r][j] - mean; s2 += (y[r][j][0] * y[r][j][0] + y[r][j][1] * y[r][j][1]) + (y[r][j][2] * y[r][j][2] + y[r][j][3] * y[r][j][3]); }
            rstd[r] = 1.0f / sqrtf(wave_sum(s2) * (1.0f / D) + LN_EPS); }
        float lg[R][NE];
#pragma unroll
        for (int r = 0; r < R; ++r)
#pragma unroll
            for (int e = 0; e < NE; ++e) lg[r][e] = 0.f;
        const f32x4* shp = HAS_NEXT ? (const f32x4*)(next_mod + (size_t)b * 3 * D) + lane : nullptr;
#pragma unroll
        for (int j = 0; j < 8; ++j) { const f32x4 g = *((const f32x4*)lng + lane + 64 * j), bb = *((const f32x4*)lnb + lane + 64 * j);
            f32x4 s0 = {0.f, 0.f, 0.f, 0.f}, s1 = {0.f, 0.f, 0.f, 0.f}; if (HAS_NEXT) { s0 = shp[64 * j]; s1 = shp[64 * j + D / 4]; }
            f32x4 r0[4], r1[4];
            if (ROUTER) {
#pragma unroll
                for (int q = 0; q < 4; ++q) { const int k = 4 * lane + 256 * j + q; r0[q] = *(const LAS f32x4*)(rw + k * 8); r1[q] = *(const LAS f32x4*)(rw + k * 8 + 4); } }
#pragma unroll
            for (int r = 0; r < R; ++r) { const f32x4 xn = y[r][j] * rstd[r] * g + bb; ((f32x4*)(xout + (size_t)(m0 + r) * D) + lane)[64 * j] = xn;
                if (HAS_NEXT) { const f32x4 hf = xn * (1.0f + s1) + s0;
                    if (H_F8) { ((unsigned*)((unsigned char*)hout + (size_t)(m0 + r) * D) + lane)[64 * j] = cvt_pk4_fp8(hf[0] * F8_SA1, hf[1] * F8_SA1, hf[2] * F8_SA1, hf[3] * F8_SA1); }
                    else { u32x2 w; w.x = cvt_pk_bf16(hf[0], hf[1]); w.y = cvt_pk_bf16(hf[2], hf[3]); ((u32x2*)(hout + (size_t)(m0 + r) * D) + lane)[64 * j] = w; }
                    if (ROUTER) {
#pragma unroll
                        for (int q = 0; q < 4; ++q) { lg[r][0] += hf[q] * r0[q][0]; lg[r][1] += hf[q] * r0[q][1]; lg[r][2] += hf[q] * r0[q][2]; lg[r][3] += hf[q] * r0[q][3];
                            lg[r][4] += hf[q] * r1[q][0]; lg[r][5] += hf[q] * r1[q][1]; lg[r][6] += hf[q] * r1[q][2]; lg[r][7] += hf[q] * r1[q][3]; } } } }
            if (ROUTER || MOE_IN) asm volatile("" ::: "memory");
        }
        if (ROUTER) {
#pragma unroll
            for (int r = 0; r < R; ++r) {
#pragma unroll
                for (int e = 0; e < NE; ++e) lg[r][e] = wave_sum(lg[r][e]);
                int e1 = 0; float v1 = lg[r][0];
#pragma unroll
                for (int e = 1; e < NE; ++e) if (lg[r][e] > v1) { v1 = lg[r][e]; e1 = e; }
                int e2 = -1; float v2 = -3.0e38f;
#pragma unroll
                for (int e = 0; e < NE; ++e) if (e != e1 && lg[r][e] > v2) { v2 = lg[r][e]; e2 = e; }
                const float ex = __expf(v2 - v1), p1 = 1.0f / (1.0f + ex), p2 = ex / (1.0f + ex);
                if (lane == 0) { ((unsigned*)(meta + META_TOKE))[m0 + r] = (unsigned)e1 | ((unsigned)e2 << 8); ((f32x2*)(meta + META_TOKP))[m0 + r] = (f32x2){p1, p2}; } }
        }
    }
}

template <bool H_I8, bool XIN_BF, bool XOUT_BF>
__device__ __forceinline__ void ln_plain(const void* xin, void* xout, const bf16* O, const float* gate_mod, const float* lng, const float* lnb, const float* next_mod, bf16* hout, float* rs, int gw, int NGW, int lane) {
    constexpr int R = 2;
    for (int m0 = R * gw; m0 < M; m0 += R * NGW) {
        const int b = m0 / SEQ;
        const f32x4* gt = (const f32x4*)(gate_mod + (size_t)b * 3 * D + 2 * D) + lane;
        const f32x4* shp = (const f32x4*)(next_mod + (size_t)b * 3 * D) + lane;
        f32x4 y[R][8]; u32x2 ow[R][8]; f32x4 gv[8];
#pragma unroll
        for (int j = 0; j < 8; ++j) { gv[j] = gt[64 * j];
#pragma unroll
            for (int r = 0; r < R; ++r) { if (XIN_BF) y[r][j] = bf4(((const u32x2*)((const bf16*)xin + (size_t)(m0 + r) * D) + lane)[64 * j]); else y[r][j] = ((const f32x4*)((const float*)xin + (size_t)(m0 + r) * D) + lane)[64 * j];
                ow[r][j] = ((const u32x2*)(O + (size_t)(m0 + r) * D) + lane)[64 * j]; } }
        __builtin_amdgcn_sched_barrier(0);
        float sum[R];
#pragma unroll
        for (int r = 0; r < R; ++r) { sum[r] = 0.f;
#pragma unroll
            for (int j = 0; j < 8; ++j) { const f32x4 v = DN_ALPHA * y[r][j] + (1.0f + gv[j]) * bf4(ow[r][j]); y[r][j] = v; sum[r] += (v[0] + v[1]) + (v[2] + v[3]); } }
        f32x4 g[4], bb[4], s0[4], s1[4];
#pragma unroll
        for (int j = 0; j < 4; ++j) { g[j] = *((const f32x4*)lng + lane + 64 * j); bb[j] = *((const f32x4*)lnb + lane + 64 * j); s0[j] = shp[64 * j]; s1[j] = shp[64 * j + D / 4]; }
        __builtin_amdgcn_sched_barrier(0);
        float rstd[R];
#pragma unroll
        for (int r = 0; r < R; ++r) { const float mean = wave_sum(sum[r]) * (1.0f / D); float s2 = 0.f;
#pragma unroll
            for (int j = 0; j < 8; ++j) { y[r][j] = y[r][j] - mean; s2 += (y[r][j][0] * y[r][j][0] + y[r][j][1] * y[r][j][1]) + (y[r][j][2] * y[r][j][2] + y[r][j][3] * y[r][j][3]); }
            rstd[r] = 1.0f / sqrtf(wave_sum(s2) * (1.0f / D) + LN_EPS); }
#pragma unroll
        for (int hh = 0; hh < 2; ++hh) {
            f32x4 g2[4], bb2[4], s02[4], s12[4];
            if (hh == 0) {
#pragma unroll
                for (int j = 0; j < 4; ++j) { g2[j] = *((const f32x4*)lng + lane + 64 * (j + 4)); bb2[j] = *((const f32x4*)lnb + lane + 64 * (j + 4)); s02[j] = shp[64 * (j + 4)]; s12[j] = shp[64 * (j + 4) + D / 4]; }
                __builtin_amdgcn_sched_barrier(0);
            }
#pragma unroll
            for (int jj = 0; jj < 4; ++jj)
#pragma unroll
                for (int r = 0; r < R; ++r) { const int j = 4 * hh + jj; const f32x4 xn = y[r][j] * rstd[r] * g[jj] + bb[jj];
                    if (XOUT_BF) { u32x2 w; w.x = cvt_pk_bf16(xn[0], xn[1]); w.y = cvt_pk_bf16(xn[2], xn[3]); ((u32x2*)((bf16*)xout + (size_t)(m0 + r) * D) + lane)[64 * j] = w; } else ((f32x4*)((float*)xout + (size_t)(m0 + r) * D) + lane)[64 * j] = xn;
                    const f32x4 hf = xn * (1.0f + s1[jj]) + s0[jj];
                    if (H_I8) { y[r][j] = hf; }
                    else { u32x2 w; w.x = cvt_pk_bf16(hf[0], hf[1]); w.y = cvt_pk_bf16(hf[2], hf[3]); ((u32x2*)(hout + (size_t)(m0 + r) * D) + lane)[64 * j] = w; } }
            if (hh == 0) {
#pragma unroll
                for (int j = 0; j < 4; ++j) { g[j] = g2[j]; bb[j] = bb2[j]; s0[j] = s02[j]; s1[j] = s12[j]; } }
        }
        if (H_I8) {
#pragma unroll
            for (int r = 0; r < R; ++r) { float amax = 0.f;
#pragma unroll
                for (int j = 0; j < 8; ++j) amax = fmaxf(amax, fmaxf(fmaxf(fabsf(y[r][j][0]), fabsf(y[r][j][1])), fmaxf(fabsf(y[r][j][2]), fabsf(y[r][j][3]))));
#pragma unroll
                for (int o = 1; o < 64; o <<= 1) amax = fmaxf(amax, __shfl_xor(amax, o));
                amax = fmaxf(amax, 1e-20f); const float q = 127.0f / amax;
                if (lane == 0) rs[m0 + r] = amax * (1.0f / 127.0f);
#pragma unroll
                for (int j = 0; j < 8; ++j) ((unsigned*)((unsigned char*)hout + (size_t)(m0 + r) * D) + lane)[64 * j] = cvt_pk4_i8(y[r][j][0] * q, y[r][j][1] * q, y[r][j][2] * q, y[r][j][3] * q); }
        }
    }
}

template <bool MOE_IN, bool HAS_NEXT, bool ROUTER, bool XIN_BF, bool XOUT_BF>
__device__ __forceinline__ void ln_phase_row(const void* xin, void* xout, const bf16* O, const bf16* O2, const float* gate_mod  , const float* lng, const float* lnb,
                                         const float* next_mod, bf16* hout, const float* router_w, float* rs, unsigned char* meta, LAS unsigned char* lds, int gw, int NGW, int tid, int lane) {
    LAS float* rw = (LAS float*)lds;
    LAS f32x4* P = (LAS f32x4*)(lds + 65536);
    constexpr int RPW = 4;
    const int mb = gw * RPW, b = mb / SEQ;
    (void)NGW;
    if (ROUTER) { for (int i = tid; i < D * NE / 4; i += 512) ((LAS f32x4*)rw)[i] = ((const f32x4*)router_w)[i]; }
    { P[tid] = ((const f32x4*)lng)[tid]; P[512 + tid] = ((const f32x4*)lnb)[tid];
      if (HAS_NEXT) { const f32x4* sh = (const f32x4*)(next_mod + (size_t)b * 3 * D); P[1024 + tid] = sh[tid]; P[1536 + tid] = sh[tid + D / 4] + 1.0f; }
      P[2048 + tid] = ((const f32x4*)(gate_mod + (size_t)b * 3 * D + 2 * D))[tid] + 1.0f; }
    __syncthreads();
    u32x2 xw[2][8], ow[2][8]; f32x4 xf[2][8];
#define LN_XPRE(buf, row) do { _Pragma("unroll") for (int j = 0; j < 8; ++j) { \
        if (XIN_BF) xw[buf][j] = ((const u32x2*)((const bf16*)xin + (size_t)(row) * D) + lane)[64 * j]; else xf[buf][j] = ((const f32x4*)((const float*)xin + (size_t)(row) * D) + lane)[64 * j]; \
        ow[buf][j] = ((const u32x2*)(O + (size_t)(row) * D) + lane)[64 * j]; } } while (0)
    if (!MOE_IN) LN_XPRE(0, mb);
#pragma unroll
    for (int k = 0; k < RPW; ++k) { const int m = mb + k;
        f32x4 y[8];
        if (MOE_IN) {
            const int p1 = ((const int*)(meta + META_POS))[2 * m], p2 = ((const int*)(meta + META_POS))[2 * m + 1];
            const f32x2 pr = ((const f32x2*)(meta + META_TOKP))[m];
            const bool t1 = p1 >= 2 * M, t2 = p2 >= 2 * M;
            const u32x2* y1 = t1 ? (const u32x2*)(O2 + (size_t)(p1 - 2 * M) * D) + lane : (const u32x2*)(O + (size_t)p1 * D) + lane;
            const u32x2* y2 = t2 ? (const u32x2*)(O2 + (size_t)(p2 - 2 * M) * D) + lane : (const u32x2*)(O + (size_t)p2 * D) + lane;
            constexpr size_t SL4 = SLAB_ELEMS / 4;
            u32x2 w1[8], w2[8], xv[8];
#pragma unroll
            for (int j = 0; j < 8; ++j) { xv[j] = ((const u32x2*)((const bf16*)xin + (size_t)m * D) + lane)[64 * j]; w1[j] = y1[64 * j]; w2[j] = y2[64 * j]; }
            __builtin_amdgcn_sched_barrier(0);
#pragma unroll
            for (int j = 0; j < 8; ++j) { f32x4 a1 = bf4(w1[j]), a2 = bf4(w2[j]);
                if (t1) a1 = (a1 + bf4(y1[64 * j + SL4])) + (bf4(y1[64 * j + 2 * SL4]) + bf4(y1[64 * j + 3 * SL4]));
                if (t2) a2 = (a2 + bf4(y2[64 * j + SL4])) + (bf4(y2[64 * j + 2 * SL4]) + bf4(y2[64 * j + 3 * SL4]));
                y[j] = DN_ALPHA * bf4(xv[j]) + P[2048 + lane + 64 * j] * (pr.x * a1 + pr.y * a2); }
        } else {
            if (k + 1 < RPW) { LN_XPRE((k + 1) & 1, m + 1); __builtin_amdgcn_sched_barrier(0); }
#pragma unroll
            for (int j = 0; j < 8; ++j) y[j] = DN_ALPHA * (XIN_BF ? bf4(xw[k & 1][j]) : xf[k & 1][j]) + P[2048 + lane + 64 * j] * bf4(ow[k & 1][j]);
        }
        float s = 0.f;
#pragma unroll
        for (int j = 0; j < 8; ++j) s += (y[j][0] + y[j][1]) + (y[j][2] + y[j][3]);
        const float mean = wave_sum(s) * (1.0f / D); float s2 = 0.f;
#pragma unroll
        for (int j = 0; j < 8; ++j) { y[j] = y[j] - mean; s2 += (y[j][0] * y[j][0] + y[j][1] * y[j][1]) + (y[j][2] * y[j][2] + y[j][3] * y[j][3]); }
        const float rstd = 1.0f / sqrtf(wave_sum(s2) * (1.0f / D) + LN_EPS);
        f32x4* xo = (f32x4*)((float*)xout + (size_t)m * D) + lane; u32x2* xob = (u32x2*)((bf16*)xout + (size_t)m * D) + lane;
        float lg[NE];
#pragma unroll
        for (int e = 0; e < NE; ++e) lg[e] = 0.f;
#pragma unroll
        for (int j = 0; j < 8; ++j) { const f32x4 xn = y[j] * rstd * P[lane + 64 * j] + P[512 + lane + 64 * j];
            if (XOUT_BF) { u32x2 w; w.x = cvt_pk_bf16(xn[0], xn[1]); w.y = cvt_pk_bf16(xn[2], xn[3]); xob[64 * j] = w; } else xo[64 * j] = xn;
            if (HAS_NEXT) { const f32x4 hf = xn * P[1536 + lane + 64 * j] + P[1024 + lane + 64 * j];
                if (ROUTER) ((unsigned*)((unsigned char*)hout + (size_t)m * D) + lane)[64 * j] = cvt_pk4_fp8(hf[0] * F8_SA1, hf[1] * F8_SA1, hf[2] * F8_SA1, hf[3] * F8_SA1);
                else y[j] = hf;
                if (ROUTER) {
#pragma unroll
                    for (int q = 0; q < 4; ++q) { const int kk = 4 * lane + 256 * j + q; const f32x4 r0 = *(const LAS f32x4*)(rw + kk * 8), r1 = *(const LAS f32x4*)(rw + kk * 8 + 4);
                        lg[0] += hf[q] * r0[0]; lg[1] += hf[q] * r0[1]; lg[2] += hf[q] * r0[2]; lg[3] += hf[q] * r0[3]; lg[4] += hf[q] * r1[0]; lg[5] += hf[q] * r1[1]; lg[6] += hf[q] * r1[2]; lg[7] += hf[q] * r1[3]; } } } }
        if (HAS_NEXT && !ROUTER) {
            float amax = 0.f;
#pragma unroll
            for (int j = 0; j < 8; ++j) amax = fmaxf(amax, fmaxf(fmaxf(fabsf(y[j][0]), fabsf(y[j][1])), fmaxf(fabsf(y[j][2]), fabsf(y[j][3]))));
#pragma unroll
            for (int o = 1; o < 64; o <<= 1) amax = fmaxf(amax, __shfl_xor(amax, o));
            amax = fmaxf(amax, 1e-20f); const float q = 127.0f / amax;
            if (lane == 0) rs[m] = amax * (1.0f / 127.0f);
#pragma unroll
            for (int j = 0; j < 8; ++j) ((unsigned*)((unsigned char*)hout + (size_t)m * D) + lane)[64 * j] = cvt_pk4_i8(y[j][0] * q, y[j][1] * q, y[j][2] * q, y[j][3] * q);
        }
        if (ROUTER) {
#pragma unroll
            for (int e = 0; e < NE; ++e) lg[e] = wave_sum(lg[e]);
            int e1 = 0; float v1 = lg[0];
#pragma unroll
            for (int e = 1; e < NE; ++e) if (lg[e] > v1) { v1 = lg[e]; e1 = e; }
            int e2 = -1; float v2 = -3.0e38f;
#pragma unroll
            for (int e = 0; e < NE; ++e) if (e != e1 && lg[e] > v2) { v2 = lg[e]; e2 = e; }
            const float ex = __expf(v2 - v1), p1 = 1.0f / (1.0f + ex), p2 = ex / (1.0f + ex);
            if (lane == 0) { ((unsigned*)(meta + META_TOKE))[m] = (unsigned)e1 | ((unsigned)e2 << 8); ((f32x2*)(meta + META_TOKP))[m] = (f32x2){p1, p2}; }
        }
    }
}
#undef LN_XPRE

__device__ __forceinline__ void moe_scatter(const bf16* H, bf16* HS, unsigned char* meta, LAS unsigned char* lds, int bid, int G, int tid, int wave, int lane) {
    LAS unsigned* cnt = (LAS unsigned*)lds;
    LAS int* spos = (LAS int*)(lds + 256);
    LAS int* sbase = (LAS int*)(lds + 1024);
    const unsigned* toke = (const unsigned*)(meta + META_TOKE);
    const int TPW = M / G, blk0 = bid * TPW;
    if (tid < 16) cnt[tid] = 0u;
    __syncthreads();
    { unsigned tot[NE], bef[NE];
#pragma unroll
      for (int e = 0; e < NE; ++e) { tot[e] = 0u; bef[e] = 0u; }
      const int tk0 = tid * 16;
#pragma unroll
      for (int q = 0; q < 4; ++q) { const u32x4 v = *((const u32x4*)(toke + tk0) + q);
#pragma unroll
          for (int j = 0; j < 4; ++j) { const unsigned w = v[j], e1 = w & 0xffu, e2 = (w >> 8) & 0xffu; const bool bf = (tk0 + 4 * q + j) < blk0;
#pragma unroll
              for (int e = 0; e < NE; ++e) { const unsigned hit = (e1 == (unsigned)e) + (e2 == (unsigned)e); tot[e] += hit; bef[e] += bf ? hit : 0u; } } }
#pragma unroll
      for (int e = 0; e < NE; ++e) { unsigned t = tot[e], b2 = bef[e];
#pragma unroll
          for (int o = 1; o < 64; o <<= 1) { t += __shfl_xor(t, o); b2 += __shfl_xor(b2, o); }
          tot[e] = t; bef[e] = b2; }
      if (lane == 0) {
#pragma unroll
          for (int e = 0; e < NE; ++e) { atomicAdd((unsigned*)&cnt[e], tot[e]); atomicAdd((unsigned*)&cnt[8 + e], bef[e]); } }
    }
    __syncthreads();
    if (tid == 0) { int base = 0; for (int e = 0; e < NE; ++e) { sbase[e] = base; sbase[8 + e] = (int)cnt[e]; base += (((int)cnt[e] + 255) >> 8) << 8; } }
    __syncthreads();
    if (wave == 0) {
        const bool act = lane < TPW; const unsigned w = act ? toke[blk0 + lane] : 0xffffu; const unsigned e1 = w & 0xffu, e2 = (w >> 8) & 0xffu;
        int pos1 = 0, pos2 = 0;
#pragma unroll
        for (int e = 0; e < NE; ++e) { const unsigned long long mk = __ballot(act && (e1 == (unsigned)e || e2 == (unsigned)e)); const int rank = __popcll(mk & ((1ull << lane) - 1ull));
            const int p = sbase[e] + (int)cnt[8 + e] + rank; if (e1 == (unsigned)e) pos1 = p; if (e2 == (unsigned)e) pos2 = p; }
        if (act) { spos[2 * lane] = pos1; spos[2 * lane + 1] = pos2; ((int*)(meta + META_POS))[2 * (blk0 + lane)] = pos1; ((int*)(meta + META_POS))[2 * (blk0 + lane) + 1] = pos2; }
    }
    __syncthreads();
#pragma unroll 1
    for (int c0 = wave; c0 < 2 * TPW; c0 += 32) { u32x4 v[4][2];
#pragma unroll
        for (int q = 0; q < 4; ++q) { const int cpy = c0 + 8 * q; const int tk = blk0 + (cpy >> 1); const u32x4* sp = (const u32x4*)((const unsigned char*)H + (size_t)tk * D) + lane;
            if (cpy < 2 * TPW) { v[q][0] = sp[0]; v[q][1] = sp[64]; } }
#pragma unroll
        for (int q = 0; q < 4; ++q) { const int cpy = c0 + 8 * q;
            if (cpy < 2 * TPW) { u32x4* d = (u32x4*)((unsigned char*)HS + (size_t)spos[cpy] * D) + lane; d[0] = v[q][0]; d[64] = v[q][1]; } } }
    for (int e = 0; e < NE; ++e) { const int c = sbase[8 + e], r = c + bid, rend = ((c + 255) >> 8) << 8;
        if (r < rend) { unsigned* d = (unsigned*)((unsigned char*)HS + (size_t)(sbase[e] + r) * D); d[tid] = 0u; } }
    if (bid == 0 && tid == 0) { int* mi = (int*)(meta + META_INTS); int tb = 0; for (int e = 0; e < NE; ++e) { mi[e] = tb; tb += (sbase[8 + e] + 255) >> 8; } mi[8] = tb; }
}

__global__ void __launch_bounds__(512, 2) fwd(Args args) {
    extern __shared__ __attribute__((aligned(16))) unsigned char lds_raw[];
    LAS unsigned char* lds = (LAS unsigned char*)lds_raw;
    unsigned char* ws = args.ws;
    volatile LAS unsigned* MISC = (volatile LAS unsigned*)(lds + LDSCTL_OFF);
    if (threadIdx.x < 64) MISC[threadIdx.x] = 0u;
    const int wave0 = __builtin_amdgcn_readfirstlane((int)threadIdx.x >> 6);
    __syncthreads();
#define IDS() int wave = wave0; asm volatile("" : "+s"(wave)); int bid = blockIdx.x; asm volatile("" : "+s"(bid)); const int G = gridDim.x; \
    const int lane = lane_id_fresh(); const int tid = wave * 64 + lane; const int vcu = (G % 8 == 0) ? (bid % 8) * (G / 8) + bid / 8 : bid; const int gw = vcu * 8 + wave, NGW = G * 8; \
    (void)lane; (void)wave; (void)vcu; (void)gw; (void)NGW; (void)bid; (void)G
    const int lo = args.ph_lo, hi = args.ph_hi;
    XcdBarrier bar; bar.bar = (unsigned*)(ws + WS_CTL) + CW_BAR; bar.x = 0; bar.st = nullptr;
    if (hi - lo > 1) bar = xcd_barrier_post((unsigned*)(ws + WS_CTL) + CW_BAR, MISC + 8);
#ifndef PH_MASK
#define PH_MASK 0xffffffffu
#endif
#define IN(k) (((PH_MASK >> (k)) & 1u) && lo <= (k) && (k) < hi)
#define SEAM(k) do { if (IN((k) + 1)) xcd_barrier(bar, wave0); } while (0)

    float* mod = (float*)(ws + WS_MOD);
    float* X = (float*)(ws + WS_X); bf16* H = (bf16*)(ws + WS_H); bf16* O = (bf16*)(ws + WS_O);
    bf16* Z = (bf16*)(ws + WS_Z); bf16* XC = (bf16*)(ws + WS_XC); bf16* PP = (bf16*)(ws + WS_PP); float* Aa = (float*)(ws + WS_A); float* Uu = (float*)(ws + WS_U); bf16* YCAT = (bf16*)(ws + WS_YCAT);
    unsigned char* meta = ws + WS_META;

    if (IN(0)) { IDS();
        if (bid == G - 1) { for (int i = tid; i < 2 * DLRU; i += 512) { const float t = -args.in[IN_LAM][i]; ((float*)(ws + WS_SP))[i] = -8.0f * (fmaxf(t, 0.f) + log1pf(__expf(-fabsf(t)))); } }
        p0_adaln(args, ws, lds, vcu, G, tid, wave, lane); __syncthreads(); convert_items_bf16(args, ws, lds, 0, T_FD, gw, NGW, wave, lane); convert_items(args, ws, lds, T_FD, T_IN, gw, NGW, wave, lane); p0_absmax(args, (unsigned*)(ws + WS_CTL) + CW_AMAX, lds, gw, NGW, tid, lane); __syncthreads(); SEAM(0); }
    if (IN(1)) { IDS(); p1_mod_rows(args.in[IN_X], mod, H, (float*)(meta + META_RS), gw, NGW, lane); convert_items(args, ws, lds, T_IN, T_FG, gw, NGW, wave, lane); SEAM(1); }


#define MIXER(l, pb) \
        if (IN(pb + 0)) { IDS(); \
            if (bid >= CV_P2_WGS) { convert_items(args, ws, lds, l == 0 ? CV_A0 : CV_B1, l == 0 ? CV_A1 : CV_C1, (bid - CV_P2_WGS) * 8 + wave, (G - CV_P2_WGS) * 8, wave, lane); __syncthreads(); } else { \
            pg8::PlainSched S; S.init_order(M / 256, DIN / 256, CV_P2_WGS, bid); S.A = (const char*)H; S.B = (const char*)(ws + WS_WIN) + (size_t)l * DIN * D; S.a_tile = (size_t)256 * D; S.b_tile = (size_t)256 * D; S.a_sh = 0; S.a_mul = 0u;     \
            pg8::EpiBf16I8 E{Z, DIN, (const float*)(meta + META_RS), (const unsigned*)(ws + WS_CTL) + CW_AMAX + 1 + l}; \
            pg8::gemm_phase<pg8::EpiBf16I8, pg8::PlainSched, 2>(lds, pg8::Gemm{D / 2, D / 2, D / 2}, S, E, wave); } \
            SEAM(pb + 0); \
        } \
          \
        if (IN(pb + 2)) { IDS(); \
            if (bid < G / 2) { const int pmq = bid >> 2, hq = bid & 3; \
              conv_tile(Z, args.in[IN_CONVW] + l * 4 * DLRU, args.in[IN_CONVB] + l * DLRU, XC, pmq, hq, tid); \
              asm volatile("s_waitcnt vmcnt(0)" ::: "memory"); __syncthreads(); \
              pg8::FixedSched S; S.pm = pmq; S.pn0 = 2 * hq; S.n = 2; S.A = (const char*)XC; S.B = (const char*)(ws + WS_WG) + (size_t)l * 2048 * 256 * 2; S.a_tile = (size_t)256 * DLRU * 2; S.b_tile = (size_t)256 * 256 * 2; S.a_sh = 1; S.a_mul = 512u; \
              pg8::EpiGates E{args.in[IN_BA] + l * DLRU, args.in[IN_BX] + l * DLRU, (const float*)(ws + WS_SP) + l * DLRU, XC, (unsigned*)Aa}; \
              pg8::gemm_phase<pg8::EpiGates, pg8::FixedSched>(lds, pg8::Gemm{DLRU, 256, 256}, S, E, wave); } \
            else { const int wq = bid - G / 2, pmq = wq >> 2, gq = wq & 3; \
              pool_tile(Z, PP, pmq, gq, tid); \
              asm volatile("s_waitcnt vmcnt(0)" ::: "memory"); __syncthreads(); \
              pg8::FixedSched S; S.pm = pmq; S.pn0 = gq; S.n = 1; S.A = (const char*)PP; S.B = (const char*)(ws + WS_WP) + (size_t)l * 1024 * 256 * 2; S.a_tile = (size_t)256 * DLRU * 2; S.b_tile = (size_t)256 * 256 * 2; S.a_sh = 0; S.a_mul = 512u; \
              pg8::EpiPool E{YCAT, D, DLRU, args.in[IN_POOLB] + l * DLRU, args.in[IN_POOLS] + l * DLRU}; \
              pg8::gemm_phase<pg8::EpiPool, pg8::FixedSched>(lds, pg8::Gemm{DLRU, 256, 256}, S, E, wave); } \
            SEAM(pb + 2); \
        } \
        if (IN(pb + 3)) { IDS(); p5_scan((const unsigned*)Aa, Z, YCAT, lds, vcu, G, tid); SEAM(pb + 3); } \
        if (IN(pb + 4)) { IDS(); \
            pg8::PlainSched S; S.init_order(M / 256, D / 256, G, bid); S.A = (const char*)YCAT; S.B = (const char*)(ws + WS_WOUT) + (size_t)l * D * D * 2; S.a_tile = (size_t)256 * D * 2; S.b_tile = (size_t)256 * D * 2; S.a_sh = 0; S.a_mul = 0u; \
            if (l == 0) {   \
              pg8::EpiLnFused E{args.in[IN_X], (bf16*)X, (unsigned char*)H, (float*)(meta + META_RS), mod + (size_t)0 * 4 * 3 * D + 2 * D, args.in[IN_LNG] + 0 * D, args.in[IN_LNB] + 0 * D, mod + (size_t)1 * 4 * 3 * D, mod + (size_t)1 * 4 * 3 * D + D, \
                                 (unsigned long long*)(ws + WS_O), (unsigned*)(ws + WS_O + 1048576), (unsigned*)(ws + WS_CTL) + CW_LNC, (unsigned*)(ws + WS_CTL) + CW_LNC + 2048, lds}; \
              pg8::gemm_phase<pg8::EpiLnFused, pg8::PlainSched>(lds, pg8::Gemm{D, D, D}, S, E, wave); \
            } else {   \
              pg8::EpiLnRouter E{(bf16*)X, (unsigned char*)H, mod + (size_t)2 * 4 * 3 * D + 2 * D, args.in[IN_LNG] + 2 * D, args.in[IN_LNB] + 2 * D, mod + (size_t)3 * 4 * 3 * D, mod + (size_t)3 * 4 * 3 * D + D, args.in[IN_ROUTER], (unsigned*)(meta + META_TOKE), (f32x2*)(meta + META_TOKP), \
                                  (unsigned long long*)(ws + WS_O), (unsigned long long*)(ws + WS_O + 1048576), (unsigned*)(ws + WS_CTL) + CW_LNC + 4096, (unsigned*)(ws + WS_CTL) + CW_LNC + 4096 + 2048, lds}; \
              pg8::gemm_phase<pg8::EpiLnRouter, pg8::PlainSched>(lds, pg8::Gemm{D, D, D}, S, E, wave); } \
            SEAM(pb + 4); \
        }

    MIXER(0, 2)
    if (IN(8)) { IDS();
        if (bid >= CV_P8_WGS) { convert_items(args, ws, lds, CV_A1, CV_B1, (bid - CV_P8_WGS) * 8 + wave, (G - CV_P8_WGS) * 8, wave, lane); __syncthreads(); } else {
        pg8::PlainSched S; S.init_order(M / 256, 2 * DFF / 256, CV_P8_WGS, bid); S.A = (const char*)H; S.B = (const char*)(ws + WS_WGU); S.a_tile = (size_t)256 * D; S.b_tile = (size_t)256 * D; S.a_sh = 0; S.a_mul = 0u;
        pg8::EpiSwigluI8F8 E{(bf16*)(ws + WS_HID), DFF, (const float*)(meta + META_RS), (const unsigned*)(ws + WS_CTL) + CW_AMAX};
        pg8::gemm_phase<pg8::EpiSwigluI8F8, pg8::PlainSched, 2>(lds, pg8::Gemm{D / 2, D / 2, D / 2}, S, E, wave); }
        SEAM(8);
    }
    if (IN(9)) { IDS();
        pg8::PlainSched S; S.init_order(M / 256, D / 256, G, bid); S.A = (const char*)(ws + WS_HID); S.B = (const char*)(ws + WS_WD); S.a_tile = (size_t)256 * DFF; S.b_tile = (size_t)256 * DFF; S.a_sh = 0; S.a_mul = 0u;
        pg8::EpiBf16 E{O, D, 0, 0, 1.0f / (F8_SH * F8_SB2)};
        pg8::gemm_phase<pg8::EpiBf16, pg8::PlainSched, 1>(lds, pg8::Gemm{DFF / 2, DFF / 2, DFF / 2}, S, E, wave);
        SEAM(9);
    }
    if (IN(10)) { IDS();
        ln_phase_row<false, true, false, true, true>(X, X, O, nullptr, mod + (size_t)1 * 4 * 3 * D, args.in[IN_LNG] + 1 * D, args.in[IN_LNB] + 1 * D, mod + (size_t)2 * 4 * 3 * D, H, nullptr, (float*)(meta + META_RS), meta, lds, gw, NGW, tid, lane);
        SEAM(10);
    }
    MIXER(1, 11)
    if (IN(17)) { IDS(); moe_scatter(H, (bf16*)(ws + WS_HS), meta, lds, bid, G, tid, wave, lane); __syncthreads(); convert_items(args, ws, lds, CV_C1, T_END, gw, NGW, wave, lane); __syncthreads(); SEAM(17); }
    if (IN(18)) { IDS();
        int tbv[9];
#pragma unroll
        for (int e = 0; e < 9; ++e) tbv[e] = __builtin_amdgcn_readfirstlane((int)__hip_atomic_load((unsigned*)(meta + META_INTS) + e, __ATOMIC_RELAXED, __HIP_MEMORY_SCOPE_AGENT));
        pg8::MoeSched S; S.init_order(tbv[8], 2 * DFE / 256, G, bid); S.A = (const char*)(ws + WS_HS); S.B = (const char*)(ws + WS_WEGU); S.a_tile = (size_t)256 * D; S.b_tile = (size_t)256 * D; S.b_exp = (size_t)2 * DFE * D;
        S.tb1 = tbv[1]; S.tb2 = tbv[2]; S.tb3 = tbv[3]; S.tb4 = tbv[4]; S.tb5 = tbv[5]; S.tb6 = tbv[6]; S.tb7 = tbv[7];
        pg8::EpiSwigluF8 E{ws + WS_HIDS, DFE, 1.0f / (F8_SA1 * F8_SB1), F8_SH};
        pg8::gemm_phase<pg8::EpiSwigluF8, pg8::MoeSched, 1>(lds, pg8::Gemm{D / 2, D / 2, D / 2}, S, E, wave);
        SEAM(18);
    }
    if (IN(19)) { IDS();
        int tbv[9];
#pragma unroll
        for (int e = 0; e < 9; ++e) tbv[e] = __builtin_amdgcn_readfirstlane((int)__hip_atomic_load((unsigned*)(meta + META_INTS) + e, __ATOMIC_RELAXED, __HIP_MEMORY_SCOPE_AGENT));
        const int Tm = tbv[8] < 64 ? tbv[8] : 64;
        { pg8::MoeSched S; S.init_order(Tm, D / 256, G, bid); S.A = (const char*)(ws + WS_HIDS); S.B = (const char*)(ws + WS_WED); S.a_tile = (size_t)256 * DFE; S.b_tile = (size_t)256 * DFE; S.b_exp = (size_t)D * DFE;
          S.tb1 = tbv[1]; S.tb2 = tbv[2]; S.tb3 = tbv[3]; S.tb4 = tbv[4]; S.tb5 = tbv[5]; S.tb6 = tbv[6]; S.tb7 = tbv[7];
          pg8::EpiBf16 E{(bf16*)(ws + WS_YBUF), D, 0, 0, 1.0f / (F8_SH * F8_SB2)};
          pg8::gemm_phase<pg8::EpiBf16, pg8::MoeSched, 1>(lds, pg8::Gemm{DFE / 2, DFE / 2, DFE / 2}, S, E, wave); }
        if (tbv[8] > 64) {
          pg8::MoeTailSched S; S.pm0 = 64; S.nsub = (tbv[8] - 64) * 8 * 4; S.G = G; S.c = bid; S.A = (const char*)(ws + WS_HIDS); S.B = (const char*)(ws + WS_WED); S.a_tile = (size_t)256 * DFE; S.b_tile = (size_t)256 * DFE; S.b_exp = (size_t)D * DFE; S.kslice = (size_t)(DFE / 4); S.bslice = (size_t)(DFE / 4) * 256;
          S.tb1 = tbv[1]; S.tb2 = tbv[2]; S.tb3 = tbv[3]; S.tb4 = tbv[4]; S.tb5 = tbv[5]; S.tb6 = tbv[6]; S.tb7 = tbv[7];
          pg8::EpiBf16 E{(bf16*)(ws + WS_SLAB), D, SLAB_ELEMS, 64, 1.0f / (F8_SH * F8_SB2)};
          pg8::gemm_phase<pg8::EpiBf16, pg8::MoeTailSched, 1>(lds, pg8::Gemm{DFE / 2, DFE / 2, DFE / 8}, S, E, wave); }
        SEAM(19);
    }
    if (IN(20)) { IDS();
        ln_phase_row<true, false, false, true, false>(X, args.out, (const bf16*)(ws + WS_YBUF), (const bf16*)(ws + WS_SLAB), mod + (size_t)3 * 4 * 3 * D, args.in[IN_LNG] + 3 * D, args.in[IN_LNB] + 3 * D, nullptr, nullptr, nullptr, nullptr, meta, lds, gw, NGW, tid, lane);
    }
#undef MIXER
#undef IN
#undef SEAM
}

extern "C" void kernel_launch(void* const* d_in, const int* in_sizes, int n_in, void* d_out, int out_size, void* d_ws, size_t ws_size, hipStream_t stream) {
    static int grid = 0;
    if (grid == 0) {
        if (n_in != 25 || out_size != M * D || ws_size < WS_END) { fprintf(stderr, "kernel_launch: unexpected sizes (n_in %d, out %d, ws %zu < %zu)\n", n_in, out_size, ws_size, (size_t)WS_END); grid = -1; return; }
        if (hipFuncSetAttribute((const void*)fwd, hipFuncAttributeMaxDynamicSharedMemorySize, LDS_BYTES) != hipSuccess) { fprintf(stderr, "kernel_launch: hipFuncSetAttribute failed\n"); grid = -1; return; }
        int dev = 0, cus = 0, per_cu = 0;
        (void)hipGetDevice(&dev); (void)hipDeviceGetAttribute(&cus, hipDeviceAttributeMultiprocessorCount, dev);
        if (hipOccupancyMaxActiveBlocksPerMultiprocessor(&per_cu, (const void*)fwd, 512, LDS_BYTES) != hipSuccess || per_cu < 1) fprintf(stderr, "kernel_launch: occupancy query reports %d\n", per_cu);
        (void)hipGetLastError();
        grid = 256;
        if (cus != 256) fprintf(stderr, "kernel_launch: device reports %d CUs; this kernel is built for 256\n", cus);
    }
    if (grid < 0) return;
    (void)hipMemsetAsync((char*)d_ws + WS_CTL, 0, CTL_ZERO_BYTES, stream);
    Args a{};
    for (int i = 0; i < 25; ++i) a.in[i] = (const float*)d_in[i];
    a.out = (float*)d_out; a.ws = (unsigned char*)d_ws;
#if MK_ONE_LAUNCH
    a.ph_lo = 0; a.ph_hi = NPHASE;
    hipLaunchKernelGGL(fwd, dim3(grid), dim3(512), LDS_BYTES, stream, a);
#else
#ifndef DUP_MASK
#define DUP_MASK 0u
#endif
    for (int p = 0; p < NPHASE; ++p) { a.ph_lo = p; a.ph_hi = p + 1; const int reps = ((DUP_MASK >> p) & 1u) ? 2 : 1;
        for (int r = 0; r < reps; ++r) hipLaunchKernelGGL(fwd, dim3(grid), dim3(512), LDS_BYTES, stream, a); }
#endif
}
```

```cpp
#include <hip/hip_runtime.h>
#include <cstdio>
#include <cstdint>

#ifndef MK_ONE_LAUNCH
#define MK_ONE_LAUNCH 1
#endif

constexpr int D = 2048, NB = 4, SEQ = 2048, M = NB * SEQ;
constexpr int DLRU = 1024, DIN = 3072, DFF = 5632, NE = 8, DFE = 7168;
constexpr int MOE_ROWS = 2 * M + NE * 256;
constexpr float LN_EPS = 1e-5f;
constexpr float DN_ALPHA = 1.41421356237309515f;
constexpr int NPHASE = 21;

#define GAS __attribute__((address_space(1)))
#define LAS __attribute__((address_space(3)))
typedef unsigned short bf16;
typedef float f32x4 __attribute__((ext_vector_type(4)));
typedef float f32x2 __attribute__((ext_vector_type(2)));
typedef unsigned u32x4 __attribute__((ext_vector_type(4)));
typedef unsigned u32x2 __attribute__((ext_vector_type(2)));
typedef short bf16x8 __attribute__((ext_vector_type(8)));

__device__ __forceinline__ unsigned cvt_pk_bf16(float lo, float hi) { unsigned r; asm volatile("v_cvt_pk_bf16_f32 %0, %1, %2" : "=v"(r) : "v"(lo), "v"(hi)); return r; }
__device__ __forceinline__ int lane_id_fresh() { int l; asm volatile("v_mbcnt_lo_u32_b32 %0, -1, 0\n\tv_mbcnt_hi_u32_b32 %0, -1, %0" : "=v"(l)); return l; }
__device__ __forceinline__ unsigned cvt_pk4_fp8(float a, float b, float c, float d) {
    a = __builtin_amdgcn_fmed3f(a, -448.f, 448.f); b = __builtin_amdgcn_fmed3f(b, -448.f, 448.f); c = __builtin_amdgcn_fmed3f(c, -448.f, 448.f); d = __builtin_amdgcn_fmed3f(d, -448.f, 448.f);
    int w = __builtin_amdgcn_cvt_pk_fp8_f32(a, b, 0, false); w = __builtin_amdgcn_cvt_pk_fp8_f32(c, d, w, true); return (unsigned)w;
}
__device__ __forceinline__ unsigned cvt_pk4_i8(float a, float b, float c, float d) {
    const int q0 = (int)__builtin_rintf(__builtin_amdgcn_fmed3f(a, -127.f, 127.f)), q1 = (int)__builtin_rintf(__builtin_amdgcn_fmed3f(b, -127.f, 127.f));
    const int q2 = (int)__builtin_rintf(__builtin_amdgcn_fmed3f(c, -127.f, 127.f)), q3 = (int)__builtin_rintf(__builtin_amdgcn_fmed3f(d, -127.f, 127.f));
    return (unsigned)(q0 & 255) | ((unsigned)(q1 & 255) << 8) | ((unsigned)(q2 & 255) << 16) | ((unsigned)q3 << 24);
}
constexpr float F8_SA1 = 16.f, F8_SB1 = 64.f, F8_SH = 8.f, F8_SB2 = 256.f;
__device__ __forceinline__ float bf_lo(unsigned w) { return __uint_as_float(w << 16); }
__device__ __forceinline__ float bf_hi(unsigned w) { return __uint_as_float(w & 0xffff0000u); }
__device__ __forceinline__ f32x4 bf4(u32x2 w) { return (f32x4){bf_lo(w.x), bf_hi(w.x), bf_lo(w.y), bf_hi(w.y)}; }
__device__ __forceinline__ float fast_sigmoid(float v) { return __builtin_amdgcn_rcpf(1.0f + __expf(-v)); }
__device__ __forceinline__ float gelu_tanh(float v) {
    const float t = 0.7978845608028654f * (v + 0.044715f * v * v * v);
    return v * fast_sigmoid(2.0f * t);
}

namespace pg8 {
#define PG8_LAS __attribute__((address_space(3)))
constexpr int BM = 256, BK = 64, HALF = 128, HTB = HALF * BK * 2  , STAGE_BYTES = 8 * HTB, NXCD = 8, WGM = 4;

__host__ __device__ __forceinline__ int lds_byte(int r, int c) { const int st = (r >> 4) * 2 + (c >> 5), rr = r & 15, cc = c & 31, ob = rr * 64 + cc * 2; return st * 1024 + (ob ^ (((ob >> 9) & 1) << 5)); }
__host__ __device__ __forceinline__ void stage_rc(int b, int& R, int& C) { const int st = b / 1024, sb = b % 1024, swz = sb ^ (((sb >> 9) & 1) << 5); R = (st >> 1) * 16 + swz / 64; C = (st & 1) * 32 + (swz % 64) / 2; }
__host__ __device__ __forceinline__ int perm32(int rho) { const int n = rho >> 4, i = rho & 15; return 8 * (i >> 2) + 4 * n + (i & 3); }

typedef int i32x4v __attribute__((ext_vector_type(4)));
typedef int i32x8v __attribute__((ext_vector_type(8)));
struct Unit { int pm, pn, ks; };
struct Gemm { int lda, ldb, K; };

struct TileOrder {
    int nM, nN, nwg, G, c;
    __device__ __forceinline__ void init_order(int nM_, int nN_, int G_, int c_) { nM = nM_; nN = nN_; nwg = nM * nN; G = G_; c = c_; }
    __device__ __forceinline__ bool next(int i, Unit& u) const {
        const long L = (long)i * G + c; if (L >= nwg) return false;
        int wgid = (int)L; { const int q = nwg / NXCD, r = nwg % NXCD, xcd = wgid % NXCD, off = wgid / NXCD; wgid = (xcd < r ? xcd * (q + 1) : r * (q + 1) + (xcd - r) * q) + off; }
        const int nig = WGM * nN, gid = wgid / nig, fm = gid * WGM, gsz = (nM - fm) < WGM ? (nM - fm) : WGM;
        u.pm = fm + ((wgid % nig) % gsz); u.pn = (wgid % nig) / gsz; u.ks = 0; return true;
    }
    __device__ __forceinline__ void a_ready(const Unit&) const {}
    __device__ __forceinline__ void done(const Unit&) const {}
};
struct PlainSched : TileOrder {
    const char* A; const char* B; size_t a_tile, b_tile; int a_sh; unsigned a_mul;
    __device__ __forceinline__ const char* a_base(const Unit& u) const { return A + (size_t)u.pm * a_tile + (size_t)((unsigned)(u.pn >> a_sh) * a_mul); }
    __device__ __forceinline__ const char* b_base(const Unit& u) const { return B + (size_t)u.pn * b_tile; }
};
struct FixedSched {
    int pm, pn0, n; const char* A; const char* B; size_t a_tile, b_tile; int a_sh; unsigned a_mul;
    __device__ __forceinline__ bool next(int i, Unit& u) const { if (i >= n) return false; u.pm = pm; u.pn = pn0 + i; u.ks = 0; return true; }
    __device__ __forceinline__ const char* a_base(const Unit& u) const { return A + (size_t)u.pm * a_tile + (size_t)((unsigned)(u.pn >> a_sh) * a_mul); }
    __device__ __forceinline__ const char* b_base(const Unit& u) const { return B + (size_t)u.pn * b_tile; }
    __device__ __forceinline__ void a_ready(const Unit&) const {}
    __device__ __forceinline__ void done(const Unit&) const {}
};
struct MoeSched {
    int nM, nN, nwg, G, c;
    const char* A; const char* B; size_t a_tile, b_tile, b_exp; int tb1, tb2, tb3, tb4, tb5, tb6, tb7;
    __device__ __forceinline__ void init_order(int nM_, int nN_, int G_, int c_) { nM = nM_; nN = nN_; nwg = nM * nN; G = G_; c = c_; }
    __device__ __forceinline__ int clip(int t) const { return t < nM ? t : nM; }
    __device__ __forceinline__ int expert(int pm) const { return __builtin_amdgcn_readfirstlane((pm >= tb1) + (pm >= tb2) + (pm >= tb3) + (pm >= tb4) + (pm >= tb5) + (pm >= tb6) + (pm >= tb7)); }
    __device__ __forceinline__ bool next(int i, Unit& u) const {
        const long L = (long)i * G + c; if (L >= nwg) return false;
        int wgid = (int)L; { const int q = nwg / NXCD, r = nwg % NXCD, xcd = wgid % NXCD, off = wgid / NXCD; wgid = (xcd < r ? xcd * (q + 1) : r * (q + 1) + (xcd - r) * q) + off; }
        const int b1 = clip(tb1), b2 = clip(tb2), b3 = clip(tb3), b4 = clip(tb4), b5 = clip(tb5), b6 = clip(tb6), b7 = clip(tb7);
        int lo = 0, hi = b1;
        if (wgid >= b1 * nN) { lo = b1; hi = b2; } if (wgid >= b2 * nN) { lo = b2; hi = b3; } if (wgid >= b3 * nN) { lo = b3; hi = b4; } if (wgid >= b4 * nN) { lo = b4; hi = b5; }
        if (wgid >= b5 * nN) { lo = b5; hi = b6; } if (wgid >= b6 * nN) { lo = b6; hi = b7; } if (wgid >= b7 * nN) { lo = b7; hi = nM; }
        const int local = wgid - lo * nN, gsz = hi - lo;
        u.pm = __builtin_amdgcn_readfirstlane(lo + local % gsz); u.pn = __builtin_amdgcn_readfirstlane(local / gsz); u.ks = 0; return true;
    }
    __device__ __forceinline__ const char* a_base(const Unit& u) const { return A + (size_t)u.pm * a_tile; }
    __device__ __forceinline__ const char* b_base(const Unit& u) const { return B + (size_t)expert(u.pm) * b_exp + (size_t)u.pn * b_tile; }
    __device__ __forceinline__ void a_ready(const Unit&) const {}
    __device__ __forceinline__ void done(const Unit&) const {}
};
struct MoeTailSched {
    int pm0, nsub, G, c; const char* A; const char* B; size_t a_tile, b_tile, b_exp, kslice, bslice; int tb1, tb2, tb3, tb4, tb5, tb6, tb7;
    __device__ __forceinline__ bool next(int i, Unit& u) const { const int j = i * G + c; if (j >= nsub) return false; const int un = j >> 2; u.ks = j & 3; u.pm = pm0 + (un >> 3); u.pn = un & 7; return true; }
    __device__ __forceinline__ int expert(int pm) const { return __builtin_amdgcn_readfirstlane((pm >= tb1) + (pm >= tb2) + (pm >= tb3) + (pm >= tb4) + (pm >= tb5) + (pm >= tb6) + (pm >= tb7)); }
    __device__ __forceinline__ const char* a_base(const Unit& u) const { return A + (size_t)u.pm * a_tile + (size_t)u.ks * kslice; }
    __device__ __forceinline__ const char* b_base(const Unit& u) const { return B + (size_t)expert(u.pm) * b_exp + (size_t)u.pn * b_tile + (size_t)u.ks * bslice; }
    __device__ __forceinline__ void a_ready(const Unit&) const {}
    __device__ __forceinline__ void done(const Unit&) const {}
};

struct EpiF32 {
    static constexpr bool PERM = false;
    float* C; int ldc;
    __device__ __forceinline__ void operator()(const f32x4 (&acc)[2][2][4][2], const Unit& u, int wr, int wc, int fr, int fq) const {
        const int row0 = u.pm * BM + wr * 64 + fr, col0 = u.pn * BM + wc * 32 + 4 * fq;
#pragma unroll
        for (int ai = 0; ai < 2; ++ai)
#pragma unroll
            for (int m = 0; m < 4; ++m) { float* rowp = C + (size_t)(row0 + ai * HALF + m * 16) * ldc + col0;
#pragma unroll
                for (int bj = 0; bj < 2; ++bj)
#pragma unroll
                    for (int n = 0; n < 2; ++n) *(f32x4*)(rowp + bj * HALF + n * 16) = acc[ai][bj][m][n]; }
    }
};
struct EpiF32Slab {
    static constexpr bool PERM = false;
    float* C; int ldc; size_t slab; int pm0;
    __device__ __forceinline__ void operator()(const f32x4 (&acc)[2][2][4][2], const Unit& u, int wr, int wc, int fr, int fq) const {
        const int row0 = (u.pm - pm0) * BM + wr * 64 + fr, col0 = u.pn * BM + wc * 32 + 4 * fq; float* base = C + (size_t)u.ks * slab;
#pragma unroll
        for (int ai = 0; ai < 2; ++ai)
#pragma unroll
            for (int m = 0; m < 4; ++m) { float* rowp = base + (size_t)(row0 + ai * HALF + m * 16) * ldc + col0;
#pragma unroll
                for (int bj = 0; bj < 2; ++bj)
#pragma unroll
                    for (int n = 0; n < 2; ++n) *(f32x4*)(rowp + bj * HALF + n * 16) = acc[ai][bj][m][n]; }
    }
};
struct EpiBf16 {
    static constexpr bool PERM = true;
    bf16* O; int ldc; size_t slab; int pm0; float scale;
    __device__ __forceinline__ void operator()(const f32x4 (&acc)[2][2][4][2], const Unit& u, int wr, int wc, int fr, int fq) const {
        const int row0 = (u.pm - pm0) * BM + wr * 64 + fr, col0 = u.pn * BM + wc * 32 + 8 * fq; bf16* base = O + (size_t)u.ks * slab;
#pragma unroll
        for (int ai = 0; ai < 2; ++ai)
#pragma unroll
            for (int m = 0; m < 4; ++m) { bf16* rowp = base + (size_t)(row0 + ai * HALF + m * 16) * ldc + col0;
#pragma unroll
                for (int bj = 0; bj < 2; ++bj) { const f32x4 v0 = acc[ai][bj][m][0] * scale, v1 = acc[ai][bj][m][1] * scale;
                    u32x4 w; w.x = cvt_pk_bf16(v0[0], v0[1]); w.y = cvt_pk_bf16(v0[2], v0[3]); w.z = cvt_pk_bf16(v1[0], v1[1]); w.w = cvt_pk_bf16(v1[2], v1[3]);
                    *(u32x4*)(rowp + bj * HALF) = w; } }
    }
};
struct EpiSwiglu {
    static constexpr bool PERM = true;
    bf16* O; int ldc;
    __device__ __forceinline__ void operator()(const f32x4 (&acc)[2][2][4][2], const Unit& u, int wr, int wc, int fr, int fq) const {
        const int row0 = u.pm * BM + wr * 64 + fr, col0 = u.pn * HALF + wc * 32 + 8 * fq;
#pragma unroll
        for (int ai = 0; ai < 2; ++ai)
#pragma unroll
            for (int m = 0; m < 4; ++m) { bf16* rowp = O + (size_t)(row0 + ai * HALF + m * 16) * ldc + col0;
                f32x4 v[2];
#pragma unroll
                for (int n = 0; n < 2; ++n) { const f32x4 g = acc[ai][0][m][n], up = acc[ai][1][m][n];
#pragma unroll
                    for (int j = 0; j < 4; ++j) v[n][j] = g[j] * up[j] * fast_sigmoid(g[j]); }
                u32x4 w; w.x = cvt_pk_bf16(v[0][0], v[0][1]); w.y = cvt_pk_bf16(v[0][2], v[0][3]); w.z = cvt_pk_bf16(v[1][0], v[1][1]); w.w = cvt_pk_bf16(v[1][2], v[1][3]);
                *(u32x4*)rowp = w; }
    }
};
struct EpiSwigluF8 {
    static constexpr bool PERM = true;
    unsigned char* O; int ldc; float inv, oscale;
    __device__ __forceinline__ void operator()(const f32x4 (&acc)[2][2][4][2], const Unit& u, int wr, int wc, int fr, int fq) const {
        const int row0 = u.pm * BM + wr * 64 + fr, col0 = u.pn * HALF + wc * 32 + 8 * fq;
#pragma unroll
        for (int ai = 0; ai < 2; ++ai)
#pragma unroll
            for (int m = 0; m < 4; ++m) { unsigned char* rowp = O + (size_t)(row0 + ai * HALF + m * 16) * ldc + col0;
                f32x4 v[2];
#pragma unroll
                for (int n = 0; n < 2; ++n) {
                    const f32x4 ex = acc[ai][0][m][n] * (-1.4426950408889634f * inv), pr = (acc[ai][0][m][n] * acc[ai][1][m][n]) * (inv * inv * oscale);
                    f32x4 t;
#pragma unroll
                    for (int j = 0; j < 4; ++j) t[j] = __builtin_amdgcn_exp2f(ex[j]);
                    t = t + 1.0f;
#pragma unroll
                    for (int j = 0; j < 4; ++j) t[j] = __builtin_amdgcn_rcpf(t[j]);
                    v[n] = pr * t; }
                u32x2 w; w.x = cvt_pk4_fp8(v[0][0], v[0][1], v[0][2], v[0][3]); w.y = cvt_pk4_fp8(v[1][0], v[1][1], v[1][2], v[1][3]);
                *(u32x2*)rowp = w; }
    }
};
struct EpiBf16I8 {
    static constexpr bool PERM = true;
    bf16* O; int ldc; const float* rs; const unsigned* amax_bits;
    __device__ __forceinline__ void operator()(const f32x4 (&acc)[2][2][4][2], const Unit& u, int wr, int wc, int fr, int fq) const {
        const int row0 = u.pm * BM + wr * 64 + fr, col0 = u.pn * BM + wc * 32 + 8 * fq;
        const float wsc = __uint_as_float(*amax_bits) * (1.0f / 127.0f);
        float rsv[8];
#pragma unroll
        for (int i = 0; i < 8; ++i) rsv[i] = rs[row0 + (i >> 2) * HALF + (i & 3) * 16];
#pragma unroll
        for (int ai = 0; ai < 2; ++ai)
#pragma unroll
            for (int m = 0; m < 4; ++m) { const int row = row0 + ai * HALF + m * 16; bf16* rowp = O + (size_t)row * ldc + col0; const float sc = rsv[ai * 4 + m] * wsc;
#pragma unroll
                for (int bj = 0; bj < 2; ++bj) { const i32x4v a0 = __builtin_bit_cast(i32x4v, acc[ai][bj][m][0]), a1 = __builtin_bit_cast(i32x4v, acc[ai][bj][m][1]);
                    u32x4 w; w.x = cvt_pk_bf16((float)a0[0] * sc, (float)a0[1] * sc); w.y = cvt_pk_bf16((float)a0[2] * sc, (float)a0[3] * sc); w.z = cvt_pk_bf16((float)a1[0] * sc, (float)a1[1] * sc); w.w = cvt_pk_bf16((float)a1[2] * sc, (float)a1[3] * sc);
                    *(u32x4*)(rowp + bj * HALF) = w; } }
    }
};
template <bool OUT_F8> struct EpiSwigluI8T {
    static constexpr bool PERM = true;
    bf16* O; int ldc; const float* rs; const unsigned* amax_bits;
    __device__ __forceinline__ void operator()(const f32x4 (&acc)[2][2][4][2], const Unit& u, int wr, int wc, int fr, int fq) const {
        const int row0 = u.pm * BM + wr * 64 + fr, col0 = u.pn * HALF + wc * 32 + 8 * fq;
        const float wsc = __uint_as_float(*amax_bits) * (1.0f / 127.0f);
        float rsv[8];
#pragma unroll
        for (int i = 0; i < 8; ++i) rsv[i] = rs[row0 + (i >> 2) * HALF + (i & 3) * 16];
#pragma unroll
        for (int ai = 0; ai < 2; ++ai)
#pragma unroll
            for (int m = 0; m < 4; ++m) { const int row = row0 + ai * HALF + m * 16; bf16* rowp = O + (size_t)row * ldc + col0; const float sc = rsv[ai * 4 + m] * wsc;
                f32x4 v[2];
#pragma unroll
                for (int n = 0; n < 2; ++n) { const i32x4v gi = __builtin_bit_cast(i32x4v, acc[ai][0][m][n]), ui = __builtin_bit_cast(i32x4v, acc[ai][1][m][n]);
                    f32x4 gf, uf;
#pragma unroll
                    for (int j = 0; j < 4; ++j) { gf[j] = (float)gi[j]; uf[j] = (float)ui[j]; }
                    const f32x4 ex = gf * (-1.4426950408889634f * sc), pr = (gf * uf) * (OUT_F8 ? sc * sc * F8_SH : sc * sc);
                    f32x4 t;
#pragma unroll
                    for (int j = 0; j < 4; ++j) t[j] = __builtin_amdgcn_exp2f(ex[j]);
                    t = t + 1.0f;
#pragma unroll
                    for (int j = 0; j < 4; ++j) t[j] = __builtin_amdgcn_rcpf(t[j]);
                    v[n] = pr * t; }
                if (OUT_F8) { u32x2 w; w.x = cvt_pk4_fp8(v[0][0], v[0][1], v[0][2], v[0][3]); w.y = cvt_pk4_fp8(v[1][0], v[1][1], v[1][2], v[1][3]);
                    *(u32x2*)((unsigned char*)O + (size_t)row * ldc + col0) = w; }
                else { u32x4 w; w.x = cvt_pk_bf16(v[0][0], v[0][1]); w.y = cvt_pk_bf16(v[0][2], v[0][3]); w.z = cvt_pk_bf16(v[1][0], v[1][1]); w.w = cvt_pk_bf16(v[1][2], v[1][3]);
                    *(u32x4*)rowp = w; } }
    }
};
typedef EpiSwigluI8T<false> EpiSwigluI8; typedef EpiSwigluI8T<true> EpiSwigluI8F8;
struct EpiGates {
    static constexpr bool PERM = false;
    const float* ba; const float* bx; const float* sp  ; const bf16* xc; unsigned* AU;
    __device__ __forceinline__ void operator()(const f32x4 (&acc)[2][2][4][2], const Unit& u, int wr, int wc, int fr, int fq) const {
        const int row0 = u.pm * BM + wr * 64 + fr, ch0 = u.pn * HALF + wc * 32 + 4 * fq;
        f32x4 bav[2], bxv[2], spv[2];
#pragma unroll
        for (int n = 0; n < 2; ++n) { bav[n] = *(const f32x4*)(ba + ch0 + n * 16); bxv[n] = *(const f32x4*)(bx + ch0 + n * 16); spv[n] = *(const f32x4*)(sp + ch0 + n * 16); }
        u32x2 xwv[8][2];
#pragma unroll
        for (int i = 0; i < 8; ++i)
#pragma unroll
            for (int n = 0; n < 2; ++n) xwv[i][n] = *(const u32x2*)(xc + (size_t)(row0 + (i >> 2) * HALF + (i & 3) * 16) * DLRU + ch0 + n * 16);
        asm volatile("" ::: "memory");
#pragma unroll
        for (int ai = 0; ai < 2; ++ai)
#pragma unroll
            for (int m = 0; m < 4; ++m) { const size_t ro = (size_t)(row0 + ai * HALF + m * 16) * DLRU + ch0;
#pragma unroll
                for (int n = 0; n < 2; ++n) {
                    const f32x4 xa = acc[ai][0][m][n] + bav[n], xx = acc[ai][1][m][n] + bxv[n];
                    const u32x2 xw = xwv[ai * 4 + m][n]; const f32x4 xv = bf4(xw);
                    f32x4 ea = xa * -1.4426950408889634f;
#pragma unroll
                    for (int j = 0; j < 4; ++j) ea[j] = __builtin_amdgcn_exp2f(ea[j]);
                    ea = ea + 1.0f;
#pragma unroll
                    for (int j = 0; j < 4; ++j) ea[j] = __builtin_amdgcn_rcpf(ea[j]);
                    const f32x4 la = spv[n] * ea;
                    f32x4 a = la * 1.4426950408889634f;
#pragma unroll
                    for (int j = 0; j < 4; ++j) a[j] = __builtin_amdgcn_exp2f(a[j]);
                    f32x4 om = 1.0f - a * a;
#pragma unroll
                    for (int j = 0; j < 4; ++j) om[j] = fmaxf(om[j], 1.0e-30f);
                    f32x4 t = xx * -1.4426950408889634f;
#pragma unroll
                    for (int j = 0; j < 4; ++j) t[j] = __builtin_amdgcn_exp2f(t[j]);
                    t = t + 1.0f;
                    f32x4 r = om * t * t;
#pragma unroll
                    for (int j = 0; j < 4; ++j) r[j] = __builtin_amdgcn_rsqf(r[j]);
                    const f32x4 uu = xv * om * r;
                    u32x4 w;
#pragma unroll
                    for (int j = 0; j < 4; ++j) w[j] = cvt_pk_bf16(la[j], uu[j]);
                    *(u32x4*)(AU + ro + n * 16) = w; }
                asm volatile("" ::: "memory"); }
    }
};
struct EpiLnFused {
    static constexpr bool PERM = true;
    const float* xin; bf16* xout; unsigned char* hout; float* rs;
    const float* gate; const float* lng; const float* lnb; const float* shift; const float* scale;
    unsigned long long* xb1; unsigned* xb2; unsigned* cnt1; unsigned* cnt2; PG8_LAS unsigned char* lds;
    __device__ __forceinline__ bool wait_cnt(unsigned* c) const {
        bool ok = false;
        for (int it = 0; it < 400000; ++it) { if ((unsigned)__builtin_amdgcn_readfirstlane(__hip_atomic_load(c, __ATOMIC_RELAXED, __HIP_MEMORY_SCOPE_AGENT)) >= 32u) { ok = true; break; } __builtin_amdgcn_s_sleep(2); }
        return ok;
    }
    __device__ __forceinline__ void operator()(f32x4 (&acc)[2][2][4][2], const Unit& u, int wr, int wc, int fr, int fq) const {
        constexpr int DD = 2048;
        const int wid = wr * 4 + wc, lane = fr + 16 * fq, tid = wid * 64 + lane;
        PG8_LAS f32x2* P = (PG8_LAS f32x2*)(lds + 131072 + 1024);
        PG8_LAS f32x2* S = P + 1024;
        const int b = u.pm >> 3, col0 = u.pn * 256 + wc * 32 + 8 * fq, row0 = u.pm * 256 + wr * 64 + fr;
        { f32x4 gv[2][2];
#pragma unroll
          for (int bj = 0; bj < 2; ++bj)
#pragma unroll
              for (int n = 0; n < 2; ++n) gv[bj][n] = *(const f32x4*)(gate + (size_t)b * 3 * DD + col0 + bj * 128 + 4 * n) + 1.0f;
#pragma unroll
          for (int ai = 0; ai < 2; ++ai)
#pragma unroll
              for (int m = 0; m < 4; ++m) { const float* xr = xin + (size_t)(row0 + ai * 128 + m * 16) * DD + col0;
                  f32x4 xv[2][2];
#pragma unroll
                  for (int bj = 0; bj < 2; ++bj)
#pragma unroll
                      for (int n = 0; n < 2; ++n) xv[bj][n] = *(const f32x4*)(xr + bj * 128 + 4 * n);
                  float sm = 0.f, sq = 0.f;
#pragma unroll
                  for (int bj = 0; bj < 2; ++bj)
#pragma unroll
                      for (int n = 0; n < 2; ++n) { const f32x4 y = DN_ALPHA * xv[bj][n] + gv[bj][n] * acc[ai][bj][m][n]; acc[ai][bj][m][n] = y;
                          sm += (y[0] + y[1]) + (y[2] + y[3]); sq += (y[0] * y[0] + y[1] * y[1]) + (y[2] * y[2] + y[3] * y[3]); }
                  sm += __shfl_xor(sm, 16); sm += __shfl_xor(sm, 32); sq += __shfl_xor(sq, 16); sq += __shfl_xor(sq, 32);
                  if (fq == 0) P[(ai * 128 + wr * 64 + m * 16 + fr) * 4 + wc] = (f32x2){sm, sq}; } }
        __syncthreads();
        if (tid < 256) { const f32x2 a = P[tid * 4 + 0], b2 = P[tid * 4 + 1], c = P[tid * 4 + 2], d = P[tid * 4 + 3];
            const float sm = (a.x + b2.x) + (c.x + d.x), sq = (a.y + b2.y) + (c.y + d.y);
            __hip_atomic_store(xb1 + ((size_t)(u.pm * 256 + tid) * 8 + u.pn), ((unsigned long long)__float_as_uint(sq) << 32) | __float_as_uint(sm), __ATOMIC_RELAXED, __HIP_MEMORY_SCOPE_AGENT);
            asm volatile("s_waitcnt vmcnt(0)" ::: "memory");
            if (lane == 0) __hip_atomic_fetch_add(cnt1 + 64 * u.pm, 1u, __ATOMIC_RELAXED, __HIP_MEMORY_SCOPE_AGENT); }
        if (wid == 0) (void)wait_cnt(cnt1 + 64 * u.pm);
        __syncthreads();
        if (tid < 256) { float sm = 0.f, sq = 0.f;
#pragma unroll
            for (int t = 0; t < 8; ++t) { const unsigned long long w = __hip_atomic_load(xb1 + ((size_t)(u.pm * 256 + tid) * 8 + t), __ATOMIC_RELAXED, __HIP_MEMORY_SCOPE_AGENT); sm += __uint_as_float((unsigned)w); sq += __uint_as_float((unsigned)(w >> 32)); }
            const float mean = sm * (1.0f / DD), var = fmaxf(sq * (1.0f / DD) - mean * mean, 0.f);
            S[tid] = (f32x2){mean, 1.0f / sqrtf(var + LN_EPS)}; }
        __syncthreads();
        { f32x4 gl[2][2], bl[2][2], sc[2][2], sh[2][2];
#pragma unroll
          for (int bj = 0; bj < 2; ++bj)
#pragma unroll
              for (int n = 0; n < 2; ++n) { const int c = col0 + bj * 128 + 4 * n; gl[bj][n] = *(const f32x4*)(lng + c); bl[bj][n] = *(const f32x4*)(lnb + c);
                  sc[bj][n] = *(const f32x4*)(scale + (size_t)b * 3 * DD + c) + 1.0f; sh[bj][n] = *(const f32x4*)(shift + (size_t)b * 3 * DD + c); }
#pragma unroll
          for (int ai = 0; ai < 2; ++ai)
#pragma unroll
              for (int m = 0; m < 4; ++m) { const int rl = ai * 128 + wr * 64 + m * 16 + fr; const f32x2 sr = S[rl]; bf16* xo = xout + (size_t)(u.pm * 256 + rl) * DD + col0;
                  float mx = 0.f;
#pragma unroll
                  for (int bj = 0; bj < 2; ++bj) { f32x4 xn[2];
#pragma unroll
                      for (int n = 0; n < 2; ++n) { xn[n] = (acc[ai][bj][m][n] - sr.x) * sr.y * gl[bj][n] + bl[bj][n]; const f32x4 hf = xn[n] * sc[bj][n] + sh[bj][n]; acc[ai][bj][m][n] = hf;
                          mx = fmaxf(mx, fmaxf(fmaxf(fabsf(hf[0]), fabsf(hf[1])), fmaxf(fabsf(hf[2]), fabsf(hf[3])))); }
                      u32x4 w; w.x = cvt_pk_bf16(xn[0][0], xn[0][1]); w.y = cvt_pk_bf16(xn[0][2], xn[0][3]); w.z = cvt_pk_bf16(xn[1][0], xn[1][1]); w.w = cvt_pk_bf16(xn[1][2], xn[1][3]);
                      *(u32x4*)(xo + bj * 128) = w; }
                  mx = fmaxf(mx, __shfl_xor(mx, 16)); mx = fmaxf(mx, __shfl_xor(mx, 32));
                  if (fq == 0) P[rl * 4 + wc] = (f32x2){mx, 0.f}; } }
        __syncthreads();
        if (tid < 256) { const float mx = fmaxf(fmaxf(P[tid * 4 + 0].x, P[tid * 4 + 1].x), fmaxf(P[tid * 4 + 2].x, P[tid * 4 + 3].x));
            __hip_atomic_store(xb2 + ((size_t)(u.pm * 256 + tid) * 8 + u.pn), __float_as_uint(mx), __ATOMIC_RELAXED, __HIP_MEMORY_SCOPE_AGENT);
            asm volatile("s_waitcnt vmcnt(0)" ::: "memory");
            if (lane == 0) __hip_atomic_fetch_add(cnt2 + 64 * u.pm, 1u, __ATOMIC_RELAXED, __HIP_MEMORY_SCOPE_AGENT); }
        if (wid == 0) (void)wait_cnt(cnt2 + 64 * u.pm);
        __syncthreads();
        if (tid < 256) { float amax = 0.f;
#pragma unroll
            for (int t = 0; t < 8; ++t) amax = fmaxf(amax, __uint_as_float(__hip_atomic_load(xb2 + ((size_t)(u.pm * 256 + tid) * 8 + t), __ATOMIC_RELAXED, __HIP_MEMORY_SCOPE_AGENT)));
            amax = fmaxf(amax, 1e-20f); S[tid] = (f32x2){127.0f / amax, 0.f};
            if (u.pn == 0) rs[u.pm * 256 + tid] = amax * (1.0f / 127.0f); }
        __syncthreads();
#pragma unroll
        for (int ai = 0; ai < 2; ++ai)
#pragma unroll
            for (int m = 0; m < 4; ++m) { const int rl = ai * 128 + wr * 64 + m * 16 + fr; const float q = S[rl].x; unsigned char* ho = hout + (size_t)(u.pm * 256 + rl) * DD + col0;
#pragma unroll
                for (int bj = 0; bj < 2; ++bj) { const f32x4 h0 = acc[ai][bj][m][0] * q, h1 = acc[ai][bj][m][1] * q;
                    u32x2 w; w.x = cvt_pk4_i8(h0[0], h0[1], h0[2], h0[3]); w.y = cvt_pk4_i8(h1[0], h1[1], h1[2], h1[3]); *(u32x2*)(ho + bj * 128) = w; } }
    }
};
template <bool XIN_BF> struct EpiLnFusedT {
    static constexpr bool PERM = true;
    static constexpr float oscale = XIN_BF ? 1.0f / (F8_SH * F8_SB2) : 1.0f;
    const float* xin; bf16* xout; unsigned char* hout; float* rs;
    const float* gate; const float* lng; const float* lnb; const float* shift; const float* scale;
    unsigned long long* xb1; unsigned* xb2; unsigned* cnt1; unsigned* cnt2; PG8_LAS unsigned char* lds;
    __device__ __forceinline__ bool wait_cnt(unsigned* c) const {
        bool ok = false;
        for (int it = 0; it < 400000; ++it) { if ((unsigned)__builtin_amdgcn_readfirstlane(__hip_atomic_load(c, __ATOMIC_RELAXED, __HIP_MEMORY_SCOPE_AGENT)) >= 32u) { ok = true; break; } __builtin_amdgcn_s_sleep(2); }
        return ok;
    }
    __device__ __forceinline__ void operator()(f32x4 (&acc)[2][2][4][2], const Unit& u, int wr, int wc, int fr, int fq) const {
        constexpr int DD = 2048;
        const int wid = wr * 4 + wc, lane = fr + 16 * fq, tid = wid * 64 + lane;
        PG8_LAS f32x2* P = (PG8_LAS f32x2*)(lds + 131072 + 1024);
        PG8_LAS f32x2* S = P + 1024;
        PG8_LAS f32x4* PV = (PG8_LAS f32x4*)(S + 256);
        const int b = u.pm >> 3, col0 = u.pn * 256 + wc * 32 + 8 * fq, row0 = u.pm * 256 + wr * 64 + fr;
        if (tid < 64) { const int c = u.pn * 256 + 4 * tid; PV[tid] = *(const f32x4*)(lng + c); PV[64 + tid] = *(const f32x4*)(lnb + c);
            PV[128 + tid] = *(const f32x4*)(scale + (size_t)b * 3 * DD + c) + 1.0f; PV[192 + tid] = *(const f32x4*)(shift + (size_t)b * 3 * DD + c); }
        { f32x4 gv[2][2];
#pragma unroll
          for (int bj = 0; bj < 2; ++bj)
#pragma unroll
              for (int n = 0; n < 2; ++n) gv[bj][n] = (*(const f32x4*)(gate + (size_t)b * 3 * DD + col0 + bj * 128 + 4 * n) + 1.0f) * oscale;
#pragma unroll
          for (int ai = 0; ai < 2; ++ai)
#pragma unroll
              for (int m = 0; m < 4; ++m) { const size_t xoff = (size_t)(row0 + ai * 128 + m * 16) * DD + col0;
                  f32x4 xv[2][2];
                  if (XIN_BF) {
#pragma unroll
                      for (int bj = 0; bj < 2; ++bj) { const u32x4 w = *(const u32x4*)((const bf16*)xin + xoff + bj * 128); xv[bj][0] = (f32x4){bf_lo(w.x), bf_hi(w.x), bf_lo(w.y), bf_hi(w.y)}; xv[bj][1] = (f32x4){bf_lo(w.z), bf_hi(w.z), bf_lo(w.w), bf_hi(w.w)}; }
                  } else {
#pragma unroll
                      for (int bj = 0; bj < 2; ++bj)
#pragma unroll
                          for (int n = 0; n < 2; ++n) xv[bj][n] = *(const f32x4*)(xin + xoff + bj * 128 + 4 * n); }
                  float sm = 0.f, sq = 0.f;
#pragma unroll
                  for (int bj = 0; bj < 2; ++bj)
#pragma unroll
                      for (int n = 0; n < 2; ++n) { const f32x4 y = DN_ALPHA * xv[bj][n] + gv[bj][n] * acc[ai][bj][m][n]; acc[ai][bj][m][n] = y;
                          sm += (y[0] + y[1]) + (y[2] + y[3]); sq += (y[0] * y[0] + y[1] * y[1]) + (y[2] * y[2] + y[3] * y[3]); }
                  sm += __shfl_xor(sm, 16); sm += __shfl_xor(sm, 32); sq += __shfl_xor(sq, 16); sq += __shfl_xor(sq, 32);
                  if (fq == 0) P[(ai * 128 + wr * 64 + m * 16 + fr) * 4 + wc] = (f32x2){sm, sq}; } }
        __syncthreads();
        if (tid < 256) { const f32x2 a = P[tid * 4 + 0], b2 = P[tid * 4 + 1], c = P[tid * 4 + 2], d = P[tid * 4 + 3];
            const float sm = (a.x + b2.x) + (c.x + d.x), sq = (a.y + b2.y) + (c.y + d.y);
            __hip_atomic_store(xb1 + ((size_t)(u.pm * 256 + tid) * 8 + u.pn), ((unsigned long long)__float_as_uint(sq) << 32) | __float_as_uint(sm), __ATOMIC_RELAXED, __HIP_MEMORY_SCOPE_AGENT);
            asm volatile("s_waitcnt vmcnt(0)" ::: "memory");
            if (lane == 0) __hip_atomic_fetch_add(cnt1 + 64 * u.pm, 1u, __ATOMIC_RELAXED, __HIP_MEMORY_SCOPE_AGENT); }
        if (wid == 0) (void)wait_cnt(cnt1 + 64 * u.pm);
        __syncthreads();
        if (tid < 256) { float sm = 0.f, sq = 0.f;
#pragma unroll
            for (int t = 0; t < 8; ++t) { const unsigned long long w = __hip_atomic_load(xb1 + ((size_t)(u.pm * 256 + tid) * 8 + t), __ATOMIC_RELAXED, __HIP_MEMORY_SCOPE_AGENT); sm += __uint_as_float((unsigned)w); sq += __uint_as_float((unsigned)(w >> 32)); }
            const float mean = sm * (1.0f / DD), var = fmaxf(sq * (1.0f / DD) - mean * mean, 0.f);
            S[tid] = (f32x2){mean, 1.0f / sqrtf(var + LN_EPS)}; }
        __syncthreads();
#pragma unroll
        for (int ai = 0; ai < 2; ++ai)
#pragma unroll
            for (int m = 0; m < 4; ++m) { const int rl = ai * 128 + wr * 64 + m * 16 + fr; const f32x2 sr = S[rl]; bf16* xo = xout + (size_t)(u.pm * 256 + rl) * DD + col0;
                float mx = 0.f;
#pragma unroll
                for (int bj = 0; bj < 2; ++bj) { f32x4 xn[2];
#pragma unroll
                    for (int n = 0; n < 2; ++n) { const int c4 = (wc * 32 + 8 * fq + bj * 128 + 4 * n) >> 2;
                        xn[n] = (acc[ai][bj][m][n] - sr.x) * sr.y * PV[c4] + PV[64 + c4]; const f32x4 hf = xn[n] * PV[128 + c4] + PV[192 + c4]; acc[ai][bj][m][n] = hf;
                        mx = fmaxf(mx, fmaxf(fmaxf(fabsf(hf[0]), fabsf(hf[1])), fmaxf(fabsf(hf[2]), fabsf(hf[3])))); }
                    u32x4 w; w.x = cvt_pk_bf16(xn[0][0], xn[0][1]); w.y = cvt_pk_bf16(xn[0][2], xn[0][3]); w.z = cvt_pk_bf16(xn[1][0], xn[1][1]); w.w = cvt_pk_bf16(xn[1][2], xn[1][3]);
                    *(u32x4*)(xo + bj * 128) = w; }
                mx = fmaxf(mx, __shfl_xor(mx, 16)); mx = fmaxf(mx, __shfl_xor(mx, 32));
                if (fq == 0) P[rl * 4 + wc] = (f32x2){mx, 0.f}; }
        __syncthreads();
        if (tid < 256) { const float mx = fmaxf(fmaxf(P[tid * 4 + 0].x, P[tid * 4 + 1].x), fmaxf(P[tid * 4 + 2].x, P[tid * 4 + 3].x));
            __hip_atomic_store(xb2 + ((size_t)(u.pm * 256 + tid) * 8 + u.pn), __float_as_uint(mx), __ATOMIC_RELAXED, __HIP_MEMORY_SCOPE_AGENT);
            asm volatile("s_waitcnt vmcnt(0)" ::: "memory");
            if (lane == 0) __hip_atomic_fetch_add(cnt2 + 64 * u.pm, 1u, __ATOMIC_RELAXED, __HIP_MEMORY_SCOPE_AGENT); }
        if (wid == 0) (void)wait_cnt(cnt2 + 64 * u.pm);
        __syncthreads();
        if (tid < 256) { float amax = 0.f;
#pragma unroll
            for (int t = 0; t < 8; ++t) amax = fmaxf(amax, __uint_as_float(__hip_atomic_load(xb2 + ((size_t)(u.pm * 256 + tid) * 8 + t), __ATOMIC_RELAXED, __HIP_MEMORY_SCOPE_AGENT)));
            amax = fmaxf(amax, 1e-20f); S[tid] = (f32x2){127.0f / amax, 0.f};
            if (u.pn == 0) rs[u.pm * 256 + tid] = amax * (1.0f / 127.0f); }
        __syncthreads();
#pragma unroll
        for (int ai = 0; ai < 2; ++ai)
#pragma unroll
            for (int m = 0; m < 4; ++m) { const int rl = ai * 128 + wr * 64 + m * 16 + fr; const float q = S[rl].x; unsigned char* ho = hout + (size_t)(u.pm * 256 + rl) * DD + col0;
#pragma unroll
                for (int bj = 0; bj < 2; ++bj) { const f32x4 h0 = acc[ai][bj][m][0] * q, h1 = acc[ai][bj][m][1] * q;
                    u32x2 w; w.x = cvt_pk4_i8(h0[0], h0[1], h0[2], h0[3]); w.y = cvt_pk4_i8(h1[0], h1[1], h1[2], h1[3]); *(u32x2*)(ho + bj * 128) = w; } }
    }
};
typedef EpiLnFusedT<true> EpiLnFusedB;
struct EpiLnRouter {
    static constexpr bool PERM = true;
    bf16* x; unsigned char* hout;
    const float* gate; const float* lng; const float* lnb; const float* shift; const float* scale;
    const float* rw; unsigned* toke; f32x2* tokp;
    unsigned long long* xb1; unsigned long long* xb3; unsigned* cnt1; unsigned* cnt2; PG8_LAS unsigned char* lds;
    __device__ __forceinline__ bool wait_cnt(unsigned* c) const {
        bool ok = false;
        for (int it = 0; it < 400000; ++it) { if ((unsigned)__builtin_amdgcn_readfirstlane(__hip_atomic_load(c, __ATOMIC_RELAXED, __HIP_MEMORY_SCOPE_AGENT)) >= 32u) { ok = true; break; } __builtin_amdgcn_s_sleep(2); }
        return ok;
    }
    __device__ __forceinline__ void operator()(f32x4 (&acc)[2][2][4][2], const Unit& u, int wr, int wc, int fr, int fq) const {
        constexpr int DD = 2048;
        const int wid = wr * 4 + wc, lane = fr + 16 * fq, tid = wid * 64 + lane;
        PG8_LAS float* RW = (PG8_LAS float*)lds;
        PG8_LAS f32x4* L2 = (PG8_LAS f32x4*)(lds + 65536);
        PG8_LAS f32x2* P = (PG8_LAS f32x2*)(lds + 131072 + 1024);
        PG8_LAS f32x2* S = P + 1024;
        PG8_LAS f32x4* PV = (PG8_LAS f32x4*)(S + 256);
        const int b = u.pm >> 3, col0 = u.pn * 256 + wc * 32 + 8 * fq, row0 = u.pm * 256 + wr * 64 + fr;
        asm volatile("s_waitcnt vmcnt(0)" ::: "memory"); __syncthreads();
        for (int i = tid; i < DD * 8 / 4; i += 512) ((PG8_LAS f32x4*)RW)[i] = ((const f32x4*)rw)[i];
        if (tid < 64) { const int c = u.pn * 256 + 4 * tid; PV[tid] = *(const f32x4*)(lng + c); PV[64 + tid] = *(const f32x4*)(lnb + c);
            PV[128 + tid] = *(const f32x4*)(scale + (size_t)b * 3 * DD + c) + 1.0f; PV[192 + tid] = *(const f32x4*)(shift + (size_t)b * 3 * DD + c); }
        { f32x4 gv[2][2];
#pragma unroll
          for (int bj = 0; bj < 2; ++bj)
#pragma unroll
              for (int n = 0; n < 2; ++n) gv[bj][n] = *(const f32x4*)(gate + (size_t)b * 3 * DD + col0 + bj * 128 + 4 * n) + 1.0f;
#pragma unroll
          for (int ai = 0; ai < 2; ++ai)
#pragma unroll
              for (int m = 0; m < 4; ++m) { const bf16* xr = x + (size_t)(row0 + ai * 128 + m * 16) * DD + col0;
                  f32x4 xv[2][2];
#pragma unroll
                  for (int bj = 0; bj < 2; ++bj) { const u32x4 w = *(const u32x4*)(xr + bj * 128); xv[bj][0] = (f32x4){bf_lo(w.x), bf_hi(w.x), bf_lo(w.y), bf_hi(w.y)}; xv[bj][1] = (f32x4){bf_lo(w.z), bf_hi(w.z), bf_lo(w.w), bf_hi(w.w)}; }
                  float sm = 0.f, sq = 0.f;
#pragma unroll
                  for (int bj = 0; bj < 2; ++bj)
#pragma unroll
                      for (int n = 0; n < 2; ++n) { const f32x4 y = DN_ALPHA * xv[bj][n] + gv[bj][n] * acc[ai][bj][m][n]; acc[ai][bj][m][n] = y;
                          sm += (y[0] + y[1]) + (y[2] + y[3]); sq += (y[0] * y[0] + y[1] * y[1]) + (y[2] * y[2] + y[3] * y[3]); }
                  sm += __shfl_xor(sm, 16); sm += __shfl_xor(sm, 32); sq += __shfl_xor(sq, 16); sq += __shfl_xor(sq, 32);
                  if (fq == 0) P[(ai * 128 + wr * 64 + m * 16 + fr) * 4 + wc] = (f32x2){sm, sq}; } }
        __syncthreads();
        if (tid < 256) { const f32x2 a = P[tid * 4 + 0], b2 = P[tid * 4 + 1], c = P[tid * 4 + 2], d = P[tid * 4 + 3];
            const float sm = (a.x + b2.x) + (c.x + d.x), sq = (a.y + b2.y) + (c.y + d.y);
            __hip_atomic_store(xb1 + ((size_t)(u.pm * 256 + tid) * 8 + u.pn), ((unsigned long long)__float_as_uint(sq) << 32) | __float_as_uint(sm), __ATOMIC_RELAXED, __HIP_MEMORY_SCOPE_AGENT);
            asm volatile("s_waitcnt vmcnt(0)" ::: "memory");
            if (lane == 0) __hip_atomic_fetch_add(cnt1 + 64 * u.pm, 1u, __ATOMIC_RELAXED, __HIP_MEMORY_SCOPE_AGENT); }
        if (wid == 0) (void)wait_cnt(cnt1 + 64 * u.pm);
        __syncthreads();
        if (tid < 256) { float sm = 0.f, sq = 0.f;
#pragma unroll
            for (int t = 0; t < 8; ++t) { const unsigned long long w = __hip_atomic_load(xb1 + ((size_t)(u.pm * 256 + tid) * 8 + t), __ATOMIC_RELAXED, __HIP_MEMORY_SCOPE_AGENT); sm += __uint_as_float((unsigned)w); sq += __uint_as_float((unsigned)(w >> 32)); }
            const float mean = sm * (1.0f / DD), var = fmaxf(sq * (1.0f / DD) - mean * mean, 0.f);
            S[tid] = (f32x2){mean, 1.0f / sqrtf(var + LN_EPS)}; }
        __syncthreads();
#pragma unroll
        for (int ai = 0; ai < 2; ++ai)
#pragma unroll
            for (int m = 0; m < 4; ++m) { const int rl = ai * 128 + wr * 64 + m * 16 + fr; const f32x2 sr = S[rl]; const size_t ro = (size_t)(u.pm * 256 + rl) * DD + col0;
                float lg[8];
#pragma unroll
                for (int e = 0; e < 8; ++e) lg[e] = 0.f;
#pragma unroll
                for (int bj = 0; bj < 2; ++bj) { f32x4 xn[2], hf[2];
#pragma unroll
                    for (int n = 0; n < 2; ++n) { const int c4 = (wc * 32 + 8 * fq + bj * 128 + 4 * n) >> 2;
                        xn[n] = (acc[ai][bj][m][n] - sr.x) * sr.y * PV[c4] + PV[64 + c4]; hf[n] = xn[n] * PV[128 + c4] + PV[192 + c4];
#pragma unroll
                        for (int q = 0; q < 4; ++q) { const int k = col0 + bj * 128 + 4 * n + q; const f32x4 r0 = *(const PG8_LAS f32x4*)(RW + k * 8), r1 = *(const PG8_LAS f32x4*)(RW + k * 8 + 4);
                            lg[0] += hf[n][q] * r0[0]; lg[1] += hf[n][q] * r0[1]; lg[2] += hf[n][q] * r0[2]; lg[3] += hf[n][q] * r0[3]; lg[4] += hf[n][q] * r1[0]; lg[5] += hf[n][q] * r1[1]; lg[6] += hf[n][q] * r1[2]; lg[7] += hf[n][q] * r1[3]; } }
                    u32x4 w; w.x = cvt_pk_bf16(xn[0][0], xn[0][1]); w.y = cvt_pk_bf16(xn[0][2], xn[0][3]); w.z = cvt_pk_bf16(xn[1][0], xn[1][1]); w.w = cvt_pk_bf16(xn[1][2], xn[1][3]);
                    *(u32x4*)(x + ro + bj * 128) = w;
                    u32x2 hw; hw.x = cvt_pk4_fp8(hf[0][0] * F8_SA1, hf[0][1] * F8_SA1, hf[0][2] * F8_SA1, hf[0][3] * F8_SA1); hw.y = cvt_pk4_fp8(hf[1][0] * F8_SA1, hf[1][1] * F8_SA1, hf[1][2] * F8_SA1, hf[1][3] * F8_SA1);
                    *(u32x2*)(hout + ro + bj * 128) = hw; }
#pragma unroll
                for (int e = 0; e < 8; ++e) { lg[e] += __shfl_xor(lg[e], 16); lg[e] += __shfl_xor(lg[e], 32); }
                if (fq == 0) { L2[(rl * 4 + wc) * 2] = (f32x4){lg[0], lg[1], lg[2], lg[3]}; L2[(rl * 4 + wc) * 2 + 1] = (f32x4){lg[4], lg[5], lg[6], lg[7]}; } }
        __syncthreads();
        if (tid < 256) { f32x4 l0 = {0.f, 0.f, 0.f, 0.f}, l1 = {0.f, 0.f, 0.f, 0.f};
#pragma unroll
            for (int w = 0; w < 4; ++w) { l0 += L2[(tid * 4 + w) * 2]; l1 += L2[(tid * 4 + w) * 2 + 1]; }
            unsigned long long* slot = xb3 + ((size_t)(u.pm * 256 + tid) * 8 + u.pn) * 4;
            __hip_atomic_store(slot + 0, ((unsigned long long)__float_as_uint(l0[1]) << 32) | __float_as_uint(l0[0]), __ATOMIC_RELAXED, __HIP_MEMORY_SCOPE_AGENT);
            __hip_atomic_store(slot + 1, ((unsigned long long)__float_as_uint(l0[3]) << 32) | __float_as_uint(l0[2]), __ATOMIC_RELAXED, __HIP_MEMORY_SCOPE_AGENT);
            __hip_atomic_store(slot + 2, ((unsigned long long)__float_as_uint(l1[1]) << 32) | __float_as_uint(l1[0]), __ATOMIC_RELAXED, __HIP_MEMORY_SCOPE_AGENT);
            __hip_atomic_store(slot + 3, ((unsigned long long)__float_as_uint(l1[3]) << 32) | __float_as_uint(l1[2]), __ATOMIC_RELAXED, __HIP_MEMORY_SCOPE_AGENT);
            asm volatile("s_waitcnt vmcnt(0)" ::: "memory");
            if (lane == 0) __hip_atomic_fetch_add(cnt2 + 64 * u.pm, 1u, __ATOMIC_RELAXED, __HIP_MEMORY_SCOPE_AGENT); }
        if (u.pn == 0) {
            if (wid == 0) (void)wait_cnt(cnt2 + 64 * u.pm);
            __syncthreads();
            if (tid < 256) { float lg[8];
#pragma unroll
                for (int e = 0; e < 8; ++e) lg[e] = 0.f;
#pragma unroll
                for (int t = 0; t < 8; ++t) { const unsigned long long* slot = xb3 + ((size_t)(u.pm * 256 + tid) * 8 + t) * 4;
#pragma unroll
                    for (int i = 0; i < 4; ++i) { const unsigned long long w = __hip_atomic_load(slot + i, __ATOMIC_RELAXED, __HIP_MEMORY_SCOPE_AGENT); lg[2 * i] += __uint_as_float((unsigned)w); lg[2 * i + 1] += __uint_as_float((unsigned)(w >> 32)); } }
                int e1 = 0; float v1 = lg[0];
#pragma unroll
                for (int e = 1; e < 8; ++e) if (lg[e] > v1) { v1 = lg[e]; e1 = e; }
                int e2 = -1; float v2 = -3.0e38f;
#pragma unroll
                for (int e = 0; e < 8; ++e) if (e != e1 && lg[e] > v2) { v2 = lg[e]; e2 = e; }
                const float ex = __expf(v2 - v1), p1 = 1.0f / (1.0f + ex), p2 = ex / (1.0f + ex); const int mrow = u.pm * 256 + tid;
                toke[mrow] = (unsigned)e1 | ((unsigned)e2 << 8); tokp[mrow] = (f32x2){p1, p2}; }
        }
    }
};
struct EpiPool {
    static constexpr bool PERM = true;
    bf16* O; int ldc; int ocol0; const float* bias; const float* scale;
    __device__ __forceinline__ void operator()(const f32x4 (&acc)[2][2][4][2], const Unit& u, int wr, int wc, int fr, int fq) const {
        const int row0 = u.pm * BM + wr * 64 + fr, pc0 = u.pn * BM + wc * 32 + 8 * fq;
        f32x4 bv[2][2], sv[2][2];
#pragma unroll
        for (int bj = 0; bj < 2; ++bj) { bv[bj][0] = *(const f32x4*)(bias + pc0 + bj * HALF); bv[bj][1] = *(const f32x4*)(bias + pc0 + bj * HALF + 4); sv[bj][0] = *(const f32x4*)(scale + pc0 + bj * HALF); sv[bj][1] = *(const f32x4*)(scale + pc0 + bj * HALF + 4); }
#pragma unroll
        for (int ai = 0; ai < 2; ++ai)
#pragma unroll
            for (int m = 0; m < 4; ++m) { bf16* rowp = O + (size_t)(row0 + ai * HALF + m * 16) * ldc + ocol0 + pc0;
#pragma unroll
                for (int bj = 0; bj < 2; ++bj) {
                    const f32x4 v0 = (acc[ai][bj][m][0] + bv[bj][0]) * sv[bj][0], v1 = (acc[ai][bj][m][1] + bv[bj][1]) * sv[bj][1];
                    u32x4 w; w.x = cvt_pk_bf16(v0[0], v0[1]); w.y = cvt_pk_bf16(v0[2], v0[3]); w.z = cvt_pk_bf16(v1[0], v1[1]); w.w = cvt_pk_bf16(v1[2], v1[3]);
                    *(u32x4*)(rowp + bj * HALF) = w; } }
    }
};

__device__ __forceinline__ const char* uniform_ptr(const char* p) {
    const unsigned long long v = (unsigned long long)p; const unsigned lo = __builtin_amdgcn_readfirstlane((unsigned)v), hi = __builtin_amdgcn_readfirstlane((unsigned)(v >> 32));
    return (const char*)(((unsigned long long)hi << 32) | lo); }
template <class Epi, class Sched, int DT = 0, bool ALIGN_EPI = true>
__device__ __forceinline__ void gemm_phase(PG8_LAS unsigned char* lds, const Gemm g, const Sched& S, const Epi& E, int wave_in) {
    int wid = wave_in; asm volatile("" : "+s"(wid));
    const int lane = lane_id_fresh();
    const int tid = wid * 64 + lane, wr = wid >> 2, wc = wid & 3, fr = lane & 15, fq = lane >> 4;
    constexpr bool FP8 = (DT == 1);
    constexpr bool BT = (DT != 0);
    const int K = g.K, nt = K / BK;
    unsigned voffA[2], voffB[2];
#pragma unroll
    for (int i = 0; i < 2; ++i) { int R, C; stage_rc(tid * 16 + i * 8192, R, C); const int Rb = Epi::PERM ? ((R & ~31) + perm32(R & 31)) : R;
        voffA[i] = (unsigned)(R * g.lda + C) * 2u; voffB[i] = BT ? (unsigned)(tid * 16 + i * 8192) : (unsigned)(Rb * g.ldb + C) * 2u; }
    const size_t kstep = (size_t)(BK * 2), kstepB = BT ? (size_t)(2 * HTB) : kstep;
    const size_t hstepA = (size_t)HALF * g.lda * 2, hstepB = BT ? (size_t)HTB : (size_t)HALF * g.ldb * 2;
    const unsigned ldsw = (unsigned)wid * 1024u;
    const unsigned ldsb = (unsigned)(size_t)lds + ldsw;
    const int aoff = lds_byte(wr * 64 + fr, fq * 8), boff = lds_byte(wc * 32 + fr, fq * 8);
#define PG8_SA(b, h) (((b) * 2 + (h)) * HTB)
#define PG8_SB(b, h) ((4 + (b) * 2 + (h)) * HTB)
#define PG8_STAGE(bufoff, gbase, voff) do { const char* _gb = uniform_ptr((const char*)(gbase)); _Pragma("unroll") for (int _i = 0; _i < 2; ++_i) { \
        unsigned _keep; asm volatile("s_nop 4\n\ts_mov_b32 %0, m0\n\ts_mov_b32 m0, %3\n\ts_nop 0\n\tglobal_load_lds_dwordx4 %1, %2\n\ts_mov_b32 m0, %0" : "=&s"(_keep) : "v"((voff)[_i]), "s"(_gb), "s"(ldsb + (unsigned)((bufoff) + _i * 8192)) : "memory"); } } while (0)
#define PG8_LDA(dst, b, h) do { if constexpr (FP8) { _Pragma("unroll") for (int m = 0; m < 4; ++m) dst##8[m] = __builtin_shufflevector(*(const PG8_LAS i32x4v*)(lds + PG8_SA(b, h) + aoff + m * 2048), *(const PG8_LAS i32x4v*)(lds + PG8_SA(b, h) + aoff + m * 2048 + 1024), 0, 1, 2, 3, 4, 5, 6, 7); } \
        else { _Pragma("unroll") for (int m = 0; m < 4; ++m) _Pragma("unroll") for (int k = 0; k < 2; ++k) dst[m][k] = *(const PG8_LAS bf16x8*)(lds + PG8_SA(b, h) + aoff + m * 2048 + k * 1024); } } while (0)
#define PG8_LDB(dst, b, h) do { if constexpr (FP8) { _Pragma("unroll") for (int n = 0; n < 2; ++n) dst##8[n] = __builtin_shufflevector(*(const PG8_LAS i32x4v*)(lds + PG8_SB(b, h) + boff + n * 2048), *(const PG8_LAS i32x4v*)(lds + PG8_SB(b, h) + boff + n * 2048 + 1024), 0, 1, 2, 3, 4, 5, 6, 7); } \
        else { _Pragma("unroll") for (int n = 0; n < 2; ++n) _Pragma("unroll") for (int k = 0; k < 2; ++k) dst[n][k] = *(const PG8_LAS bf16x8*)(lds + PG8_SB(b, h) + boff + n * 2048 + k * 1024); } } while (0)
#define PG8_CAT(x0, x1) __builtin_shufflevector(__builtin_bit_cast(i32x4v, x0), __builtin_bit_cast(i32x4v, x1), 0, 1, 2, 3, 4, 5, 6, 7)
#define PG8_MMA(ai, bj, At, Bt) do { __builtin_amdgcn_s_setprio(1); \
        if constexpr (FP8) { _Pragma("unroll") for (int m = 0; m < 4; ++m) _Pragma("unroll") for (int n = 0; n < 2; ++n) \
            acc[ai][bj][m][n] = __builtin_amdgcn_mfma_scale_f32_16x16x128_f8f6f4(Bt##8[n], At##8[m], acc[ai][bj][m][n], 0, 0, 0, 0x7F7F7F7F, 0, 0x7F7F7F7F); } \
        else if constexpr (DT == 2) { _Pragma("unroll") for (int m = 0; m < 4; ++m) _Pragma("unroll") for (int n = 0; n < 2; ++n) _Pragma("unroll") for (int k = 0; k < 2; ++k) \
            acc[ai][bj][m][n] = __builtin_bit_cast(f32x4, __builtin_amdgcn_mfma_i32_16x16x64_i8(__builtin_bit_cast(i32x4v, Bt[n][k]), __builtin_bit_cast(i32x4v, At[m][k]), __builtin_bit_cast(i32x4v, acc[ai][bj][m][n]), 0, 0, 0)); } \
        else { _Pragma("unroll") for (int m = 0; m < 4; ++m) _Pragma("unroll") for (int n = 0; n < 2; ++n) _Pragma("unroll") for (int k = 0; k < 2; ++k) \
            acc[ai][bj][m][n] = __builtin_amdgcn_mfma_f32_16x16x32_bf16(Bt[n][k], At[m][k], acc[ai][bj][m][n], 0, 0, 0); } \
        __builtin_amdgcn_s_setprio(0); } while (0)
#define PG8_WAIT_V(n) asm volatile("s_waitcnt vmcnt(" #n ")" ::: "memory")
#define PG8_WAIT_L(n) asm volatile("s_waitcnt lgkmcnt(" #n ")" ::: "memory")
#define PG8_BAR __builtin_amdgcn_s_barrier()
#define PG8_SCHED __builtin_amdgcn_sched_barrier(0)
    Unit cur, nxt; int ui = 0;
    if (!S.next(0, cur)) return;
    f32x4 acc[2][2][4][2];
#pragma unroll
    for (int a = 0; a < 2; ++a)
#pragma unroll
        for (int b = 0; b < 2; ++b)
#pragma unroll
            for (int m = 0; m < 4; ++m)
#pragma unroll
                for (int n = 0; n < 2; ++n) acc[a][b][m][n] = (f32x4){0.f, 0.f, 0.f, 0.f};
    bf16x8 At[4][2], B0[2][2], B1[2][2]; i32x8v At8[4], B08[2], B18[2];
    (void)At; (void)B0; (void)B1; (void)At8; (void)B08; (void)B18;
    const char* cA = S.a_base(cur); const char* cB = S.b_base(cur);
    S.a_ready(cur);
    PG8_STAGE(PG8_SB(0, 0), cB, voffB); PG8_STAGE(PG8_SB(0, 1), cB + hstepB, voffB); PG8_STAGE(PG8_SA(0, 0), cA, voffA); PG8_STAGE(PG8_SA(0, 1), cA + hstepA, voffA);
    if (wr == 1) PG8_BAR;
    PG8_WAIT_V(2); PG8_BAR;
    PG8_STAGE(PG8_SB(1, 0), cB + kstepB, voffB); PG8_STAGE(PG8_SA(1, 0), cA + kstep, voffA); PG8_STAGE(PG8_SB(1, 1), cB + hstepB + kstepB, voffB);
    PG8_WAIT_V(6); PG8_BAR;
    for (;;) {
        const bool has_next = S.next(ui + 1, nxt);
        const char* nA = has_next ? S.a_base(nxt) : cA; const char* nB = has_next ? S.b_base(nxt) : cB;
        for (int t = 0; t < nt; t += 2) {
            const bool last = (t == nt - 2);
            const char* a1 = cA + (size_t)(t + 1) * kstep;
            const char* a2 = last ? nA : cA + (size_t)(t + 2) * kstep; const char* b2 = last ? nB : cB + (size_t)(t + 2) * kstepB;
            const char* a3 = a2 + kstep; const char* b3 = b2 + kstepB;
            if (last && has_next) S.a_ready(nxt);
            PG8_LDB(B0, 0, 0); PG8_LDB(B1, 0, 1); PG8_SCHED; PG8_LDA(At, 0, 0); PG8_STAGE(PG8_SA(1, 1), a1 + hstepA, voffA);
            PG8_WAIT_V(8); PG8_WAIT_L(0); PG8_BAR; PG8_MMA(0, 0, At, B0); PG8_MMA(0, 1, At, B1); PG8_BAR; PG8_SCHED;
            PG8_LDA(At, 0, 1); PG8_STAGE(PG8_SB(0, 0), b2, voffB); PG8_STAGE(PG8_SB(0, 1), b2 + hstepB, voffB); PG8_STAGE(PG8_SA(0, 0), a2, voffA);
            PG8_WAIT_V(8); PG8_WAIT_L(0); PG8_BAR; PG8_MMA(1, 0, At, B0); PG8_MMA(1, 1, At, B1); PG8_BAR; PG8_SCHED;
            PG8_LDB(B0, 1, 0); PG8_LDB(B1, 1, 1); PG8_SCHED; PG8_LDA(At, 1, 0); PG8_STAGE(PG8_SA(0, 1), a2 + hstepA, voffA);
            PG8_WAIT_V(8); PG8_WAIT_L(0); PG8_BAR; PG8_MMA(0, 0, At, B0); PG8_MMA(0, 1, At, B1); PG8_BAR; PG8_SCHED;
            PG8_LDA(At, 1, 1); PG8_STAGE(PG8_SB(1, 0), b3, voffB); PG8_STAGE(PG8_SB(1, 1), b3 + hstepB, voffB); PG8_STAGE(PG8_SA(1, 0), a3, voffA);
            PG8_WAIT_V(8); PG8_WAIT_L(0); PG8_BAR; PG8_MMA(1, 0, At, B0); PG8_MMA(1, 1, At, B1); PG8_BAR; PG8_SCHED;
        }
        if constexpr (ALIGN_EPI) { if (wr == 0) PG8_BAR; }
        { const int l2 = lane_id_fresh(); E(acc, cur, wr, wc, l2 & 15, l2 >> 4); } S.done(cur);
        if (!has_next) break;
#pragma unroll
        for (int a = 0; a < 2; ++a)
#pragma unroll
            for (int b = 0; b < 2; ++b)
#pragma unroll
                for (int m = 0; m < 4; ++m)
#pragma unroll
                    for (int n = 0; n < 2; ++n) acc[a][b][m][n] = (f32x4){0.f, 0.f, 0.f, 0.f};
        cur = nxt; cA = nA; cB = nB; ++ui;
        if constexpr (ALIGN_EPI) { if (wr == 1) PG8_BAR; }
    }
    PG8_WAIT_V(0);
    if constexpr (!ALIGN_EPI) { if (wr == 0) PG8_BAR; }
    PG8_BAR;
#undef PG8_SA
#undef PG8_SB
#undef PG8_STAGE
#undef PG8_LDA
#undef PG8_LDB
#undef PG8_MMA
#undef PG8_CAT
#undef PG8_WAIT_V
#undef PG8_WAIT_L
#undef PG8_BAR
#undef PG8_SCHED
}
}

constexpr size_t MiB = 1u << 20;
constexpr size_t WS_CTL = 0, CTL_ZERO_BYTES = 96 * 1024;
constexpr size_t WS_MOD = 1 * MiB;
constexpr size_t WS_SP = 1 * MiB + 512 * 1024;
constexpr size_t WS_META = 2 * MiB;
constexpr size_t META_TOKE = 0, META_TOKP = 64 * 1024, META_POS = 192 * 1024, META_INTS = 320 * 1024;
constexpr size_t WS_WIN = 4 * MiB;
constexpr size_t WS_WOUT = WS_WIN + 24 * MiB;
constexpr size_t WS_WG = WS_WOUT + 16 * MiB;
constexpr size_t WS_WP = WS_WG + 2 * MiB;
constexpr size_t WS_WGU = WS_WP + 1 * MiB;
constexpr size_t WS_WD = WS_WGU + 44 * MiB;
constexpr size_t WS_WEGU = WS_WD + 22 * MiB;
constexpr size_t WS_WED = WS_WEGU + 448 * MiB;
constexpr size_t WS_X = WS_WED + 224 * MiB;
constexpr size_t WS_H = WS_X + 64 * MiB;
constexpr size_t WS_O = WS_H + 32 * MiB;
constexpr size_t WS_R = WS_O + 64 * MiB;
constexpr size_t WS_Z = WS_R;
constexpr size_t WS_XC = WS_Z + 48 * MiB;
constexpr size_t WS_PP = WS_XC + 16 * MiB;
constexpr size_t WS_A = WS_PP + 16 * MiB;
constexpr size_t WS_U = WS_A + 32 * MiB;
constexpr size_t WS_YCAT = WS_U + 32 * MiB;
constexpr size_t WS_HID = WS_R;
constexpr size_t WS_HS = WS_R;
constexpr size_t WS_HIDS = WS_HS + 72 * MiB;
constexpr size_t WS_YBUF = WS_HIDS + 252 * MiB;
constexpr size_t WS_SLAB = WS_YBUF + 144 * MiB;
constexpr size_t SLAB_ELEMS = (size_t)2048 * 2048;
constexpr size_t WS_END = WS_SLAB + 64 * MiB;
static_assert(WS_YCAT + 32 * MiB <= WS_END && WS_HID + 88 * MiB <= WS_END, "overlay");
constexpr int CW_AMAX = 512;
constexpr size_t META_RS = 512 * 1024;
constexpr int CW_LNC = 8192;
constexpr int CW_LNC2 = 16384;
constexpr int CW_BAR = 1024;

constexpr int RING_BYTES = 131072;
constexpr int LDSCTL_OFF = RING_BYTES;
constexpr int LDS_BYTES = 147456;

#define XB_TMO      128
#define XB_XCNT(j)  (256  + 64 * (j))
#define XB_XSUB(j)  (1280 + 64 * (j))
#define XB_XGEN(j)  (2304 + 64 * (j))
#define XB_TOP      3328
#define XB_TOPGEN   3392
#define XCD_BAR_WORDS 3456
#define XB_SPIN_CAP (1u << 18)
static_assert((CW_BAR + XCD_BAR_WORDS) * 4 <= (int)CTL_ZERO_BYTES, "barrier words inside the memset region");

__device__ __forceinline__ unsigned xb_ld(unsigned* p)              { return __hip_atomic_load(p, __ATOMIC_RELAXED, __HIP_MEMORY_SCOPE_AGENT); }
__device__ __forceinline__ unsigned xb_add(unsigned* p, unsigned v) { return __hip_atomic_fetch_add(p, v, __ATOMIC_RELAXED, __HIP_MEMORY_SCOPE_AGENT); }
__device__ __forceinline__ unsigned xb_xcc_id() { return (unsigned)__builtin_amdgcn_s_getreg((3 << 11) | 20) & 0xFu; }
#define XB_SPIN(cond, bar) do { unsigned _sp = 0; while (cond) { __builtin_amdgcn_s_sleep(1); \
    if ((++_sp & 255u) == 0u) { if (xb_ld(&(bar)[XB_TMO])) break; if (_sp > XB_SPIN_CAP) { atomicAdd(&(bar)[XB_TMO], 1u); break; } } } } while (0)

struct XcdBarrier { unsigned* bar; unsigned x; volatile LAS unsigned* st; };

__device__ __forceinline__ XcdBarrier xcd_barrier_post(unsigned* bar, volatile LAS unsigned* st) {
    XcdBarrier b; b.bar = bar; b.x = xb_xcc_id(); b.st = st;
    if (threadIdx.x == 0) (void)xb_add(&bar[XB_XCNT(b.x)], 1u);
    return b;
}
__device__ __forceinline__ bool xb_is_thread0(int wave) { return wave == 0 && lane_id_fresh() == 0; }
__device__ __forceinline__ void xcd_barrier_complete(unsigned* bar, unsigned x, unsigned& nloc, unsigned& nx) {
    const unsigned G = gridDim.x * gridDim.y * gridDim.z;
    unsigned sum, cnt, mine, sp = 0u;
    for (;;) {
        sum = 0u; cnt = 0u; mine = 0u;
#pragma unroll
        for (unsigned j = 0; j < 16; ++j) { const unsigned c = xb_ld(&bar[XB_XCNT(j)]); sum += c; cnt += (c > 0u) ? 1u : 0u; mine = (j == x) ? c : mine; }
        if (sum == G) break;
        __builtin_amdgcn_s_sleep(1);
        if ((++sp & 255u) == 0u) { if (xb_ld(&bar[XB_TMO])) break; if (sp > XB_SPIN_CAP) { atomicAdd(&bar[XB_TMO], 1u); break; } }
    }
    nloc = mine > 0u ? mine : 1u; nx = cnt > 0u ? cnt : 1u;
}
__device__ __forceinline__ void xcd_barrier(const XcdBarrier& b, int wave) {
    asm volatile("s_waitcnt vmcnt(0)" ::: "memory");
    __syncthreads();
    if (xb_is_thread0(wave)) {
        unsigned* bar = b.bar;
        __builtin_amdgcn_s_waitcnt(0);
        unsigned nloc = b.st[0], nx = b.st[1];
        if (nloc == 0u) { xcd_barrier_complete(bar, b.x, nloc, nx); b.st[0] = nloc; b.st[1] = nx; }
        const unsigned old = xb_add(&bar[XB_XSUB(b.x)], 1u);
        const unsigned gen = old / nloc;
        if (old + 1u == (gen + 1u) * nloc) {
            __builtin_amdgcn_fence(__ATOMIC_RELEASE, "agent");
            asm volatile("s_waitcnt vmcnt(0)" ::: "memory");
            const unsigned og = xb_add(&bar[XB_TOP], 1u);
            const unsigned tg = og / nx;
            if (og + 1u == (tg + 1u) * nx) xb_add(&bar[XB_TOPGEN], 1u);
            else XB_SPIN(xb_ld(&bar[XB_TOPGEN]) == tg, bar);
            __builtin_amdgcn_fence(__ATOMIC_ACQUIRE, "agent");
            xb_add(&bar[XB_XGEN(b.x)], 1u);
            asm volatile("s_waitcnt vmcnt(0)" ::: "memory");
        } else {
            XB_SPIN(xb_ld(&bar[XB_XGEN(b.x)]) == gen, bar);
            __builtin_amdgcn_fence(__ATOMIC_ACQUIRE, "agent");
            asm volatile("s_waitcnt vmcnt(0)" ::: "memory");
        }
    }
    __syncthreads();
}

#define LDS_WAIT() asm volatile("s_waitcnt lgkmcnt(0)" ::: "memory")
__device__ __forceinline__ float wave_sum(float v) {
#pragma unroll
    for (int o = 1; o < 64; o <<= 1) v += __shfl_xor(v, o);
    return v;
}

struct TItem { const float* src; unsigned char* dst; int N, ldb, f8; float scale; };
__device__ __forceinline__ void titem_load(const TItem& t, f32x4 (&v)[8], int lane) {
    const float* p = t.src + (size_t)(8 * (lane >> 3)) * t.N + 4 * (lane & 7);
#pragma unroll
    for (int i = 0; i < 8; ++i) v[i] = __builtin_nontemporal_load((const f32x4*)(p + (size_t)i * t.N));
}
__device__ __forceinline__ void titem_store(const TItem& t, const f32x4 (&v)[8], LAS float* scr, int lane) {
    (void)scr;
    {
        unsigned char* d = t.dst + (size_t)(4 * (lane & 7)) * t.ldb + 16 * (lane >> 3);
#pragma unroll
        for (int q = 0; q < 4; ++q) { u32x4 o; o.x = cvt_pk_bf16(v[0][q], v[1][q]); o.y = cvt_pk_bf16(v[2][q], v[3][q]); o.z = cvt_pk_bf16(v[4][q], v[5][q]); o.w = cvt_pk_bf16(v[6][q], v[7][q]);
            *(u32x4*)(d + (size_t)q * t.ldb) = o; }
    }
}

struct Args { const float* in[25]; float* out; unsigned char* ws; int ph_lo, ph_hi; };
enum { IN_X = 0, IN_C, IN_ADAW, IN_ADAB, IN_LNG, IN_LNB, IN_WIN, IN_CONVW, IN_CONVB, IN_WA, IN_BA, IN_WX, IN_BX, IN_LAM, IN_POOLW, IN_POOLB, IN_POOLS, IN_WOUT,
       IN_FG, IN_FU, IN_FD, IN_ROUTER, IN_EG, IN_EU, IN_ED };

constexpr int I_IN = 32 * 48, I_OUT = 32 * 64, I_SM = 32, I_FG = 32 * 88, I_FD = 88 * 32, I_EG = 32 * 112, I_ED = 112 * 32;
constexpr int LATE_WGS = 5, LATE_K = 770;
constexpr int T_OUT = 0, T_LRU = T_OUT + 2 * I_OUT, T_POOL = T_LRU + 16 * I_SM, T_FD = T_POOL + 8 * I_SM, T_IN = T_FD + I_FD, T_FG = T_IN + 2 * I_IN, T_ED = T_FG + 2 * I_FG, T_EG = T_ED + 8 * I_ED - LATE_WGS * LATE_K, T_LATE = T_EG + 16 * I_EG, T_END = T_LATE + LATE_WGS * LATE_K;

#ifndef CV_P2_WGS
#define CV_P2_WGS 128
#endif
#ifndef CV_P8_WGS
#define CV_P8_WGS 141
#endif
#ifndef CV_N_P2
#define CV_N_P2 17075
#endif
#ifndef CV_N_P8
#define CV_N_P8 53648
#endif
constexpr int CV_A0 = T_FG, CV_A1 = CV_A0 + CV_N_P2, CV_B1 = CV_A1 + CV_N_P8, CV_C1 = CV_B1 + CV_N_P2;
static_assert(CV_C1 == T_LATE, "conversion chunks: the GEMM-phase slots cover everything up to the late expert-down items");
__device__ __forceinline__ int moe_spare_wgs(int T) { const int units = T * (2 * DFE / 256), R = (units + 255) >> 8, gmin = (units + R - 1) / R; const int sp = 256 - gmin; return sp < 0 ? 0 : (sp < LATE_WGS ? sp : LATE_WGS); }
__device__ __forceinline__ bool titem_decode(const Args& args, unsigned char* ws, int it, int it_end, TItem& t) {
    if (it >= it_end) return false;
    const float* src; bf16* dst; int N, ldt, nblk, rowbase, mode, r, f8 = 0; float scale = 1.0f;
    if (it < T_LRU) { r = it - T_OUT; const int l = r / I_OUT; r -= l * I_OUT; src = args.in[IN_WOUT] + (size_t)l * D * D; N = D; nblk = D / 32; dst = (bf16*)(ws + WS_WOUT) + (size_t)l * D * D; ldt = D; rowbase = 0; mode = 0; }
    else if (it < T_POOL) { r = it - T_LRU; const int q = r / I_SM; r -= q * I_SM; const int l = q >> 3, ax = (q >> 2) & 1, h = q & 3;
        src = args.in[ax ? IN_WX : IN_WA] + (size_t)(l * 4 + h) * 65536; N = 256; nblk = 8; dst = (bf16*)(ws + WS_WG) + (size_t)l * 2048 * 256; ldt = 256; rowbase = h * 512 + ax * 128; mode = 1; }
    else if (it < T_FD) { r = it - T_POOL; const int q = r / I_SM; r -= q * I_SM; const int l = q >> 2, gq = q & 3;
        src = args.in[IN_POOLW] + (size_t)(l * 4 + gq) * 65536; N = 256; nblk = 8; dst = (bf16*)(ws + WS_WP) + (size_t)l * 1024 * 256; ldt = 256; rowbase = gq * 256; mode = 0; }
    else if (it < T_IN) { r = it - T_FD; src = args.in[IN_FD]; N = D; nblk = D / 64; dst = (bf16*)(ws + WS_WD); ldt = DFF / 128; rowbase = 0; mode = 0; f8 = 1; scale = F8_SB2; }
    else if (it < T_FG) { r = it - T_IN; const int l = r / I_IN; r -= l * I_IN; src = args.in[IN_WIN] + (size_t)l * D * DIN; N = DIN; nblk = DIN / 64; dst = (bf16*)(ws + WS_WIN + (size_t)l * DIN * D); ldt = D / 128; rowbase = 0; mode = 0; f8 = 2;
        scale = 127.0f / __uint_as_float(*((const unsigned*)(ws + WS_CTL) + CW_AMAX + 1 + l)); }
    else if (it < T_ED) { r = it - T_FG; const int gu = r / I_FG; r -= gu * I_FG; src = args.in[gu ? IN_FU : IN_FG]; N = DFF; nblk = DFF / 64; dst = (bf16*)(ws + WS_WGU); ldt = D / 128; rowbase = gu * 128; mode = 1; f8 = 2;
        scale = 127.0f / __uint_as_float(*((const unsigned*)(ws + WS_CTL) + CW_AMAX)); }
    else if (it < T_EG || it >= T_LATE) { r = it < T_EG ? it - T_ED : it - T_LATE + (8 * I_ED - LATE_WGS * LATE_K); const int e = r / I_ED; r -= e * I_ED; src = args.in[IN_ED] + (size_t)e * DFE * D; N = D; nblk = D / 64; dst = (bf16*)(ws + WS_WED + (size_t)e * D * DFE); ldt = DFE / 128; rowbase = 0; mode = 0; f8 = 1; scale = F8_SB2; }
    else { r = it - T_EG; const int q = r / I_EG; r -= q * I_EG; const int e = q >> 1, gu = q & 1;
        src = args.in[gu ? IN_EU : IN_EG] + (size_t)e * D * DFE; N = DFE; nblk = DFE / 64; dst = (bf16*)(ws + WS_WEGU + (size_t)e * 2 * DFE * D); ldt = D / 128; rowbase = gu * 128; mode = 1; f8 = 1; scale = F8_SB1; }
    const int kb = r / nblk, nb = r - kb * nblk, n0 = (f8 ? 64 : 32) * nb, k0 = 64 * kb;
    const int drow0 = mode ? rowbase + (n0 >> 7) * 256 + (n0 & 127) : rowbase + n0;
    t.src = src + (size_t)k0 * N + n0; t.N = N; t.f8 = f8; t.scale = scale;
    if (f8) { t.dst = (unsigned char*)dst + (size_t)(((drow0 >> 8) * ldt + (k0 >> 7)) * 2 + ((drow0 >> 7) & 1)) * 16384 + (2 * ((drow0 & 127) >> 4) + ((k0 >> 6) & 1)) * 1024; t.ldb = 0; }
    else { t.dst = (unsigned char*)dst + ((size_t)drow0 * ldt + k0) * 2; t.ldb = ldt * 2; }
    return true;
}
__device__ __forceinline__ void titem_load16(const TItem& t, f32x4 (&v)[16], int lane) {
    const float* p = t.src + (size_t)(16 * (lane >> 4)) * t.N + 4 * (lane & 15);
#pragma unroll
    for (int i = 0; i < 16; ++i) v[i] = __builtin_nontemporal_load((const f32x4*)(p + (size_t)i * t.N));
}
__device__ __forceinline__ void titem_store16(const TItem& t, const f32x4 (&v)[16], int lane) {
    const int g = lane >> 4, c = lane & 15, cp = c & 7, Rl = 32 * (c >> 3) + 16 * (cp & 1) + 4 * (cp >> 1), rr0 = Rl & 15;
    unsigned char* d = t.dst + (Rl >> 4) * 2048 + rr0 * 64 + ((16 * g) ^ (rr0 >= 8 ? 32 : 0)); const float sc = t.scale;
    if (t.f8 == 2) {
#pragma unroll
        for (int q = 0; q < 4; ++q) { u32x4 o; o.x = cvt_pk4_i8(v[0][q] * sc, v[1][q] * sc, v[2][q] * sc, v[3][q] * sc); o.y = cvt_pk4_i8(v[4][q] * sc, v[5][q] * sc, v[6][q] * sc, v[7][q] * sc);
            o.z = cvt_pk4_i8(v[8][q] * sc, v[9][q] * sc, v[10][q] * sc, v[11][q] * sc); o.w = cvt_pk4_i8(v[12][q] * sc, v[13][q] * sc, v[14][q] * sc, v[15][q] * sc); *(u32x4*)(d + 64 * q) = o; }
    } else {
#pragma unroll
        for (int q = 0; q < 4; ++q) { u32x4 o; o.x = cvt_pk4_fp8(v[0][q] * sc, v[1][q] * sc, v[2][q] * sc, v[3][q] * sc); o.y = cvt_pk4_fp8(v[4][q] * sc, v[5][q] * sc, v[6][q] * sc, v[7][q] * sc);
            o.z = cvt_pk4_fp8(v[8][q] * sc, v[9][q] * sc, v[10][q] * sc, v[11][q] * sc); o.w = cvt_pk4_fp8(v[12][q] * sc, v[13][q] * sc, v[14][q] * sc, v[15][q] * sc); *(u32x4*)(d + 64 * q) = o; }
    }
}
__device__ __forceinline__ void convert_items_bf16(const Args& args, unsigned char* ws, LAS unsigned char* lds, int it0, int it_end, int w, int nw, int wave, int lane) {
    LAS float* scr = (LAS float*)(lds + wave * 16384);
    TItem t0, t1, t2, t3; f32x4 v0[8], v1[8], v2[8], v3[8];
    int it = it0 + w;
    bool h0 = titem_decode(args, ws, it, it_end, t0), h1, h2, h3; if (h0) titem_load(t0, v0, lane); it += nw;
    h1 = titem_decode(args, ws, it, it_end, t1); if (h1) titem_load(t1, v1, lane); it += nw;
    h2 = titem_decode(args, ws, it, it_end, t2); if (h2) titem_load(t2, v2, lane); it += nw;
    for (;;) {
        if (!h0) break; h3 = titem_decode(args, ws, it, it_end, t3); if (h3) titem_load(t3, v3, lane); it += nw; titem_store(t0, v0, scr, lane);
        if (!h1) break; h0 = titem_decode(args, ws, it, it_end, t0); if (h0) titem_load(t0, v0, lane); it += nw; titem_store(t1, v1, scr, lane);
        if (!h2) break; h1 = titem_decode(args, ws, it, it_end, t1); if (h1) titem_load(t1, v1, lane); it += nw; titem_store(t2, v2, scr, lane);
        if (!h3) break; h2 = titem_decode(args, ws, it, it_end, t2); if (h2) titem_load(t2, v2, lane); it += nw; titem_store(t3, v3, scr, lane);
    }
}
__device__ __forceinline__ void convert_items(const Args& args, unsigned char* ws, LAS unsigned char* lds, int it0, int it_end, int w, int nw, int wave, int lane) {
    (void)lds; (void)wave;
    TItem t0, t1; f32x4 v0[16], v1[16];
    int it = it0 + w;
    bool h0 = titem_decode(args, ws, it, it_end, t0), h1; if (h0) titem_load16(t0, v0, lane); it += nw;
    for (;;) {
        if (!h0) break; h1 = titem_decode(args, ws, it, it_end, t1); if (h1) titem_load16(t1, v1, lane); it += nw; titem_store16(t0, v0, lane);
        if (!h1) break; h0 = titem_decode(args, ws, it, it_end, t0); if (h0) titem_load16(t0, v0, lane); it += nw; titem_store16(t1, v1, lane);
    }
}

__device__ __forceinline__ float absmax_span(const float* w, int n4, int gw, int NGW, int lane) {
    float mx = 0.f;
#pragma unroll 1
    for (int i0 = gw * 64 + lane; i0 < n4; i0 += NGW * 64 * 8) { f32x4 a[8];
#pragma unroll
        for (int q = 0; q < 8; ++q) { const int i = i0 + q * NGW * 64; a[q] = (i < n4) ? __builtin_nontemporal_load((const f32x4*)w + i) : (f32x4){0.f, 0.f, 0.f, 0.f}; }
#pragma unroll
        for (int q = 0; q < 8; ++q) mx = fmaxf(mx, fmaxf(fmaxf(fabsf(a[q][0]), fabsf(a[q][1])), fmaxf(fabsf(a[q][2]), fabsf(a[q][3])))); }
#pragma unroll
    for (int o = 1; o < 64; o <<= 1) mx = fmaxf(mx, __shfl_xor(mx, o));
    return mx;
}
__device__ __forceinline__ void p0_absmax(const Args& args, unsigned* amax_bits, LAS unsigned char* lds, int gw, int NGW, int tid, int lane) {
    const float m0 = fmaxf(absmax_span(args.in[IN_FG], D * DFF / 4, gw, NGW, lane), absmax_span(args.in[IN_FU], D * DFF / 4, gw, NGW, lane));
    const float m1 = absmax_span(args.in[IN_WIN], D * DIN / 4, gw, NGW, lane), m2 = absmax_span(args.in[IN_WIN] + (size_t)D * DIN, D * DIN / 4, gw, NGW, lane);
    LAS float* red = (LAS float*)lds;
    if (lane == 0) { red[(tid >> 6) * 3 + 0] = m0; red[(tid >> 6) * 3 + 1] = m1; red[(tid >> 6) * 3 + 2] = m2; }
    __syncthreads();
    if (tid < 3) { float m = red[tid];
#pragma unroll
        for (int w = 1; w < 8; ++w) m = fmaxf(m, red[w * 3 + tid]);
        (void)__hip_atomic_fetch_max(amax_bits + tid, __float_as_uint(m), __ATOMIC_RELAXED, __HIP_MEMORY_SCOPE_AGENT); }
}

__device__ __forceinline__ void p0_adaln(const Args& args, unsigned char* ws, LAS unsigned char* lds, int vcu, int G, int tid, int wave, int lane) {
    LAS float* cact = (LAS float*)lds;
    LAS float* red = (LAS float*)(lds + 32768);
    for (int i = tid; i < NB * D; i += 512) { const float v = args.in[IN_C][i]; cact[i] = v * fast_sigmoid(v); }
    __syncthreads();
    float* mod = (float*)(ws + WS_MOD);
    for (int item = vcu; item < 256; item += G) {
        const int ls = item >> 6, cb = item & 63;
        const int lc = lane < 48 ? lane : 47;
        const float* W = args.in[IN_ADAW] + (size_t)ls * D * 3 * D + cb * 96 + lc * 2;
        f32x2 acc[4];
#pragma unroll
        for (int b = 0; b < 4; ++b) acc[b] = (f32x2){0.f, 0.f};
        const int kbeg = wave * 256;
#pragma unroll 1
        for (int k0 = kbeg; k0 < kbeg + 256; k0 += 16) { f32x2 wv[16];
#pragma unroll
            for (int i = 0; i < 16; ++i) wv[i] = __builtin_nontemporal_load((const f32x2*)(W + (size_t)(k0 + i) * (3 * D)));
#pragma unroll
            for (int i = 0; i < 16; ++i) {
#pragma unroll
                for (int b = 0; b < 4; ++b) { const float cv = cact[b * D + k0 + i]; acc[b] += wv[i] * cv; } } }
        if (lane < 48) {
#pragma unroll
            for (int b = 0; b < 4; ++b) { red[(wave * 4 + b) * 96 + lane * 2] = acc[b].x; red[(wave * 4 + b) * 96 + lane * 2 + 1] = acc[b].y; } }
        __syncthreads();
        if (tid < 384) { const int b = tid / 96, cc = tid - b * 96; float s = args.in[IN_ADAB][ls * 3 * D + cb * 96 + cc];
#pragma unroll
          for (int w = 0; w < 8; ++w) s += red[(w * 4 + b) * 96 + cc];
          mod[(size_t)(ls * 4 + b) * 3 * D + cb * 96 + cc] = s; }
        __syncthreads();
    }
}

__device__ __forceinline__ void p1_mod_rows(const float* x, const float* mod_ls, bf16* h, float* rs, int gw, int NGW, int lane) {
    (void)NGW;
    const int mb = 4 * gw, b = mb / SEQ; const f32x4* sh = (const f32x4*)(mod_ls + (size_t)b * 3 * D) + lane;
    f32x4 xv[2][8], s0[8], s1[8];
#pragma unroll
    for (int j = 0; j < 8; ++j) { s0[j] = sh[64 * j]; s1[j] = sh[64 * j + D / 4] + 1.0f; xv[0][j] = ((const f32x4*)(x + (size_t)mb * D) + lane)[64 * j]; }
#pragma unroll
    for (int k = 0; k < 4; ++k) { const int m = mb + k;
        if (k + 1 < 4) {
#pragma unroll
            for (int j = 0; j < 8; ++j) xv[(k + 1) & 1][j] = ((const f32x4*)(x + (size_t)(m + 1) * D) + lane)[64 * j];
            __builtin_amdgcn_sched_barrier(0);
        }
        float amax = 0.f;
#pragma unroll
        for (int j = 0; j < 8; ++j) { const f32x4 o = xv[k & 1][j] * s1[j] + s0[j]; xv[k & 1][j] = o; amax = fmaxf(amax, fmaxf(fmaxf(fabsf(o[0]), fabsf(o[1])), fmaxf(fabsf(o[2]), fabsf(o[3])))); }
#pragma unroll
        for (int o = 1; o < 64; o <<= 1) amax = fmaxf(amax, __shfl_xor(amax, o));
        amax = fmaxf(amax, 1e-20f); const float q = 127.0f / amax;
        if (lane == 0) rs[m] = amax * (1.0f / 127.0f);
#pragma unroll
        for (int j = 0; j < 8; ++j) ((unsigned*)((unsigned char*)h + (size_t)m * D) + lane)[64 * j] = cvt_pk4_i8(xv[k & 1][j][0] * q, xv[k & 1][j][1] * q, xv[k & 1][j][2] * q, xv[k & 1][j][3] * q);
    }
}

__device__ __forceinline__ void p3_conv_pool(const bf16* Z, const float* convw, const float* convb, bf16* XC, bf16* PP, int vcu, int G, int tid) {
    const int c0 = 2 * tid;
    const f32x2 w0 = *(const f32x2*)(convw + c0), w1 = *(const f32x2*)(convw + 1024 + c0), w2 = *(const f32x2*)(convw + 2048 + c0), w3 = *(const f32x2*)(convw + 3072 + c0), cb = *(const f32x2*)(convb + c0);
    const int win = 2 << (tid >> 7);
    for (int item = vcu; item < NB * (SEQ / 32); item += G) {
        const int b = item / (SEQ / 32), t0 = (item - b * (SEQ / 32)) * 32;
        const bf16* zb = Z + (size_t)b * SEQ * DIN;
        unsigned cr[35], pr[47];
#pragma unroll
        for (int i = 0; i < 35; ++i) { const int t = t0 - 3 + i; cr[i] = *(const unsigned*)(zb + (size_t)(t < 0 ? 0 : t) * DIN + c0); }
#pragma unroll
        for (int i = 0; i < 47; ++i) { const int t = t0 - 15 + i; pr[i] = *(const unsigned*)(zb + (size_t)(t < 0 ? 0 : t) * DIN + 2048 + c0); }
        if (t0 == 0) {
#pragma unroll
            for (int i = 0; i < 3; ++i) cr[i] = 0u;
#pragma unroll
            for (int i = 0; i < 15; ++i) pr[i] = 0u;
        }
#pragma unroll
        for (int i = 0; i < 32; ++i) { const f32x2 xm3 = {bf_lo(cr[i]), bf_hi(cr[i])}, xm2 = {bf_lo(cr[i + 1]), bf_hi(cr[i + 1])}, xm1 = {bf_lo(cr[i + 2]), bf_hi(cr[i + 2])}, x0 = {bf_lo(cr[i + 3]), bf_hi(cr[i + 3])};
            const f32x2 y = cb + w0 * xm3 + w1 * xm2 + w2 * xm1 + w3 * x0;
            *(unsigned*)(XC + (size_t)(b * SEQ + t0 + i) * DLRU + c0) = cvt_pk_bf16(y.x, y.y); }
        f32x2 sacc = {0.f, 0.f};
#pragma unroll
        for (int i = 0; i < 15; ++i) { if (i >= 16 - win) sacc += (f32x2){bf_lo(pr[i]), bf_hi(pr[i])}; }
#pragma unroll
        for (int i = 0; i < 32; ++i) { const int t = t0 + i; const f32x2 xt = {bf_lo(pr[15 + i]), bf_hi(pr[15 + i])};
            sacc += xt; const float cnt = (float)((t + 1) < win ? (t + 1) : win);
            const f32x2 p = {sacc.x / cnt - xt.x, sacc.y / cnt - xt.y};
            *(unsigned*)(PP + (size_t)(b * SEQ + t) * DLRU + c0) = cvt_pk_bf16(p.x, p.y);
            const unsigned q2 = pr[15 + i - 1], q4 = pr[15 + i - 3], q8 = pr[15 + i - 7], q16 = pr[15 + i - 15];
            const unsigned q = win == 2 ? q2 : (win == 4 ? q4 : (win == 8 ? q8 : q16));
            sacc -= (f32x2){bf_lo(q), bf_hi(q)}; }
    }
}

__device__ __forceinline__ void conv_tile(const bf16* Z, const float* convw, const float* convb, bf16* XC, int pm, int h, int tid) {
    const int c0 = 256 * h + 4 * (tid & 63), b = pm >> 3, t0 = (pm & 7) * 256 + (tid >> 6) * 32;
    const f32x4 w0 = *(const f32x4*)(convw + c0), w1 = *(const f32x4*)(convw + 1024 + c0), w2 = *(const f32x4*)(convw + 2048 + c0), w3 = *(const f32x4*)(convw + 3072 + c0), cb = *(const f32x4*)(convb + c0);
    const bf16* zb = Z + (size_t)b * SEQ * DIN + c0;
    u32x2 cr[35];
    if (t0 == 0) {
#pragma unroll
        for (int i = 0; i < 3; ++i) cr[i] = (u32x2){0u, 0u};
#pragma unroll
        for (int i = 3; i < 35; ++i) cr[i] = *(const u32x2*)(zb + (size_t)(i - 3) * DIN);
    } else { const bf16* p0 = zb + (size_t)(t0 - 3) * DIN;
#pragma unroll
        for (int i = 0; i < 35; ++i) cr[i] = *(const u32x2*)(p0 + (size_t)i * DIN); }
    bf16* xo = XC + (size_t)(b * SEQ + t0) * DLRU + c0;
#pragma unroll
    for (int i = 0; i < 32; ++i) { const f32x4 y = cb + w0 * bf4(cr[i]) + w1 * bf4(cr[i + 1]) + w2 * bf4(cr[i + 2]) + w3 * bf4(cr[i + 3]);
        u32x2 o; o.x = cvt_pk_bf16(y[0], y[1]); o.y = cvt_pk_bf16(y[2], y[3]); *(u32x2*)(xo + (size_t)i * DLRU) = o; }
}
__device__ __forceinline__ void pool_tile(const bf16* Z, bf16* PP, int pm, int g, int tid) {
    const int c0 = 256 * g + 4 * (tid & 63), b = pm >> 3, t0 = (pm & 7) * 256 + (tid >> 6) * 32, win = 2 << g;
    const bf16* zb = Z + (size_t)b * SEQ * DIN + 2048 + c0;
    u32x2 pr[47];
    if (t0 == 0) {
#pragma unroll
        for (int i = 0; i < 15; ++i) pr[i] = (u32x2){0u, 0u};
#pragma unroll
        for (int i = 15; i < 47; ++i) pr[i] = *(const u32x2*)(zb + (size_t)(i - 15) * DIN);
    } else { const bf16* p0 = zb + (size_t)(t0 - 15) * DIN;
#pragma unroll
        for (int i = 0; i < 47; ++i) pr[i] = *(const u32x2*)(p0 + (size_t)i * DIN); }
    f32x4 sacc = {0.f, 0.f, 0.f, 0.f};
#pragma unroll
    for (int i = 0; i < 15; ++i) { if (i >= 16 - win) sacc += bf4(pr[i]); }
    bf16* po = PP + (size_t)(b * SEQ + t0) * DLRU + c0;
#pragma unroll
    for (int i = 0; i < 32; ++i) { const int t = t0 + i; const f32x4 xt = bf4(pr[15 + i]);
        sacc += xt; const float rc = __builtin_amdgcn_rcpf((float)((t + 1) < win ? (t + 1) : win));
        const f32x4 p = sacc * rc - xt;
        u32x2 o; o.x = cvt_pk_bf16(p[0], p[1]); o.y = cvt_pk_bf16(p[2], p[3]); *(u32x2*)(po + (size_t)i * DLRU) = o;
        const u32x2 q2 = pr[15 + i - 1], q4 = pr[15 + i - 3], q8 = pr[15 + i - 7], q16 = pr[15 + i - 15];
        const u32x2 q = win == 2 ? q2 : (win == 4 ? q4 : (win == 8 ? q8 : q16));
        sacc -= bf4(q); }
}

__device__ __forceinline__ void p5_scan(const unsigned* AU, const bf16* Z, bf16* YCAT, LAS unsigned char* lds, int vcu, int G, int tid) {
    LAS float* sP = (LAS float*)lds; LAS float* sH = sP + 512;
    const int c = tid & 15, seg = tid >> 4;
    for (int item = vcu; item < NB * (DLRU / 16); item += G) {
        const int b = item / (DLRU / 16), ch = (item - b * (DLRU / 16)) * 16 + c;
        const size_t row0 = (size_t)b * SEQ + seg * 64;
        const unsigned* ap = AU + row0 * DLRU + ch;
        float Ls = 0.f, H = 0.f;
#pragma unroll 1
        for (int i0 = 0; i0 < 64; i0 += 16) { unsigned wv[16];
#pragma unroll
            for (int i = 0; i < 16; ++i) wv[i] = ap[(size_t)(i0 + i) * DLRU];
#pragma unroll
            for (int i = 0; i < 16; ++i) { const float la = bf_lo(wv[i]); H = __expf(la) * H + bf_hi(wv[i]); Ls += la; } }
        sP[tid] = __expf(Ls); sH[tid] = H;
        __syncthreads();
        float h = 0.f;
        for (int s2 = 0; s2 < seg; ++s2) h = sP[s2 * 16 + c] * h + sH[s2 * 16 + c];
        const bf16* gp = Z + row0 * DIN + 1024 + ch; bf16* yp = YCAT + row0 * D + ch;
#pragma unroll 1
        for (int i0 = 0; i0 < 64; i0 += 8) { unsigned wv[8]; bf16 gv[8];
#pragma unroll
            for (int i = 0; i < 8; ++i) { wv[i] = ap[(size_t)(i0 + i) * DLRU]; gv[i] = gp[(size_t)(i0 + i) * DIN]; }
#pragma unroll
            for (int i = 0; i < 8; ++i) { h = __expf(bf_lo(wv[i])) * h + bf_hi(wv[i]); const float gz = __uint_as_float((unsigned)gv[i] << 16);
                yp[(size_t)(i0 + i) * D] = (bf16)(cvt_pk_bf16(h * gelu_tanh(gz), 0.f) & 0xffffu); } }
        __syncthreads();
    }
}

template <bool MOE_IN, bool HAS_NEXT, bool ROUTER, bool H_F8 = false, int RR = 4>
__device__ __forceinline__ void ln_phase(const float* __restrict__ xin, float* __restrict__ xout,     const bf16* O, const bf16* O2, const float* gate_mod  , const float* lng, const float* lnb,
                                         const float* next_mod, bf16* hout, const float* router_w, unsigned char* meta, LAS unsigned char* lds, int gw, int NGW, int tid, int lane) {
    LAS float* rw = (LAS float*)lds;
    if (ROUTER) { for (int i = tid; i < D * NE / 4; i += 512) ((LAS f32x4*)rw)[i] = ((const f32x4*)router_w)[i]; __syncthreads(); }
    constexpr size_t SL4 = SLAB_ELEMS / 4;
    constexpr int R = RR;
    for (int m0 = R * gw; m0 < M; m0 += R * NGW) {
        const int b = m0 / SEQ;
        const f32x4* gt = (const f32x4*)(gate_mod + (size_t)b * 3 * D + 2 * D) + lane;
        f32x4 y[R][8]; float sum[R];
#pragma unroll
        for (int r = 0; r < R; ++r) sum[r] = 0.f;
        const u32x2* yp1[R]; const u32x2* yp2[R]; f32x2 pr[R]; bool tl1[R], tl2[R];
        if (MOE_IN) {
#pragma unroll
            for (int r = 0; r < R; ++r) { const int p1 = ((const int*)(meta + META_POS))[2 * (m0 + r)], p2 = ((const int*)(meta + META_POS))[2 * (m0 + r) + 1]; pr[r] = ((const f32x2*)(meta + META_TOKP))[m0 + r];
                tl1[r] = p1 >= 2 * M; tl2[r] = p2 >= 2 * M;
                yp1[r] = tl1[r] ? (const u32x2*)(O2 + (size_t)(p1 - 2 * M) * D) + lane : (const u32x2*)(O + (size_t)p1 * D) + lane;
                yp2[r] = tl2[r] ? (const u32x2*)(O2 + (size_t)(p2 - 2 * M) * D) + lane : (const u32x2*)(O + (size_t)p2 * D) + lane; }
        }
#pragma unroll
        for (int jc = 0; jc < 4; ++jc) {
            f32x4 xv[R][2], ov[R][2], gv[2];
#pragma unroll
            for (int jj = 0; jj < 2; ++jj) { const int j = 2 * jc + jj; gv[jj] = gt[64 * j];
#pragma unroll
                for (int r = 0; r < R; ++r) { xv[r][jj] = ((const f32x4*)(xin + (size_t)(m0 + r) * D) + lane)[64 * j];
                    if (MOE_IN) { f32x4 a1 = bf4(yp1[r][64 * j]), a2 = bf4(yp2[r][64 * j]);
                        if (tl1[r]) a1 = (a1 + bf4(yp1[r][64 * j + SL4])) + (bf4(yp1[r][64 * j + 2 * SL4]) + bf4(yp1[r][64 * j + 3 * SL4]));
                        if (tl2[r]) a2 = (a2 + bf4(yp2[r][64 * j + SL4])) + (bf4(yp2[r][64 * j + 2 * SL4]) + bf4(yp2[r][64 * j + 3 * SL4]));
                        ov[r][jj] = pr[r].x * a1 + pr[r].y * a2; }
                    else ov[r][jj] = bf4(((const u32x2*)(O + (size_t)(m0 + r) * D) + lane)[64 * j]); } }
#pragma unroll
            for (int jj = 0; jj < 2; ++jj)
#pragma unroll
                for (int r = 0; r < R; ++r) { const f32x4 v = DN_ALPHA * xv[r][jj] + (1.0f + gv[jj]) * ov[r][jj]; y[r][2 * jc + jj] = v; sum[r] += (v[0] + v[1]) + (v[2] + v[3]); }
            if (ROUTER || MOE_IN) asm volatile("" ::: "memory");
        }
        float rstd[R];
#pragma unroll
        for (int r = 0; r < R; ++r) { const float mean = wave_sum(sum[r]) * (1.0f / D); float s2 = 0.f;
#pragma unroll
            for (int j = 0; j < 8; ++j) { y[r][j] = y[r][j] - mean; s2 += (y[r][j][0] * y[r][j][0] + y[r][j][1] * y[r][j][1]) + (y[r][j][2] * y[r][j][2] + y[r][j][3] * y[r][j][3]); }
            rstd[r] = 1.0f / sqrtf(wave_sum(s2) * (1.0f / D) + LN_EPS); }
        float lg[R][NE];
#pragma unroll
        for (int r = 0; r < R; ++r)
#pragma unroll
            for (int e = 0; e < NE; ++e) lg[r][e] = 0.f;
        const f32x4* shp = HAS_NEXT ? (const f32x4*)(next_mod + (size_t)b * 3 * D) + lane : nullptr;
#pragma unroll
        for (int j = 0; j < 8; ++j) { const f32x4 g = *((const f32x4*)lng + lane + 64 * j), bb = *((const f32x4*)lnb + lane + 64 * j);
            f32x4 s0 = {0.f, 0.f, 0.f, 0.f}, s1 = {0.f, 0.f, 0.f, 0.f}; if (HAS_NEXT) { s0 = shp[64 * j]; s1 = shp[64 * j + D / 4]; }
            f32x4 r0[4], r1[4];
            if (ROUTER) {
#pragma unroll
                for (int q = 0; q < 4; ++q) { const int k = 4 * lane + 256 * j + q; r0[q] = *(const LAS f32x4*)(rw + k * 8); r1[q] = *(const LAS f32x4*)(rw + k * 8 + 4); } }
#pragma unroll
            for (int r = 0; r < R; ++r) { const f32x4 xn = y[r][j] * rstd[r] * g + bb; ((f32x4*)(xout + (size_t)(m0 + r) * D) + lane)[64 * j] = xn;
                if (HAS_NEXT) { const f32x4 hf = xn * (1.0f + s1) + s0;
                    if (H_F8) { ((unsigned*)((unsigned char*)hout + (size_t)(m0 + r) * D) + lane)[64 * j] = cvt_pk4_fp8(hf[0] * F8_SA1, hf[1] * F8_SA1, hf[2] * F8_SA1, hf[3] * F8_SA1); }
                    else { u32x2 w; w.x = cvt_pk_bf16(hf[0], hf[1]); w.y = cvt_pk_bf16(hf[2], hf[3]); ((u32x2*)(hout + (size_t)(m0 + r) * D) + lane)[64 * j] = w; }
                    if (ROUTER) {
#pragma unroll
                        for (int q = 0; q < 4; ++q) { lg[r][0] += hf[q] * r0[q][0]; lg[r][1] += hf[q] * r0[q][1]; lg[r][2] += hf[q] * r0[q][2]; lg[r][3] += hf[q] * r0[q][3];
                            lg[r][4] += hf[q] * r1[q][0]; lg[r][5] += hf[q] * r1[q][1]; lg[r][6] += hf[q] * r1[q][2]; lg[r][7] += hf[q] * r1[q][3]; } } } }
            if (ROUTER || MOE_IN) asm volatile("" ::: "memory");
        }
        if (ROUTER) {
#pragma unroll
            for (int r = 0; r < R; ++r) {
#pragma unroll
                for (int e = 0; e < NE; ++e) lg[r][e] = wave_sum(lg[r][e]);
                int e1 = 0; float v1 = lg[r][0];
#pragma unroll
                for (int e = 1; e < NE; ++e) if (lg[r][e] > v1) { v1 = lg[r][e]; e1 = e; }
                int e2 = -1; float v2 = -3.0e38f;
#pragma unroll
                for (int e = 0; e < NE; ++e) if (e != e1 && lg[r][e] > v2) { v2 = lg[r][e]; e2 = e; }
                const float ex = __expf(v2 - v1), p1 = 1.0f / (1.0f + ex), p2 = ex / (1.0f + ex);
                if (lane == 0) { ((unsigned*)(meta + META_TOKE))[m0 + r] = (unsigned)e1 | ((unsigned)e2 << 8); ((f32x2*)(meta + META_TOKP))[m0 + r] = (f32x2){p1, p2}; } }
        }
    }
}

template <bool H_I8, bool XIN_BF, bool XOUT_BF>
__device__ __forceinline__ void ln_plain(const void* xin, void* xout, const bf16* O, const float* gate_mod, const float* lng, const float* lnb, const float* next_mod, bf16* hout, float* rs, int gw, int NGW, int lane) {
    constexpr int R = 2;
    for (int m0 = R * gw; m0 < M; m0 += R * NGW) {
        const int b = m0 / SEQ;
        const f32x4* gt = (const f32x4*)(gate_mod + (size_t)b * 3 * D + 2 * D) + lane;
        const f32x4* shp = (const f32x4*)(next_mod + (size_t)b * 3 * D) + lane;
        f32x4 y[R][8]; u32x2 ow[R][8]; f32x4 gv[8];
#pragma unroll
        for (int j = 0; j < 8; ++j) { gv[j] = gt[64 * j];
#pragma unroll
            for (int r = 0; r < R; ++r) { if (XIN_BF) y[r][j] = bf4(((const u32x2*)((const bf16*)xin + (size_t)(m0 + r) * D) + lane)[64 * j]); else y[r][j] = ((const f32x4*)((const float*)xin + (size_t)(m0 + r) * D) + lane)[64 * j];
                ow[r][j] = ((const u32x2*)(O + (size_t)(m0 + r) * D) + lane)[64 * j]; } }
        __builtin_amdgcn_sched_barrier(0);
        float sum[R];
#pragma unroll
        for (int r = 0; r < R; ++r) { sum[r] = 0.f;
#pragma unroll
            for (int j = 0; j < 8; ++j) { const f32x4 v = DN_ALPHA * y[r][j] + (1.0f + gv[j]) * bf4(ow[r][j]); y[r][j] = v; sum[r] += (v[0] + v[1]) + (v[2] + v[3]); } }
        f32x4 g[4], bb[4], s0[4], s1[4];
#pragma unroll
        for (int j = 0; j < 4; ++j) { g[j] = *((const f32x4*)lng + lane + 64 * j); bb[j] = *((const f32x4*)lnb + lane + 64 * j); s0[j] = shp[64 * j]; s1[j] = shp[64 * j + D / 4]; }
        __builtin_amdgcn_sched_barrier(0);
        float rstd[R];
#pragma unroll
        for (int r = 0; r < R; ++r) { const float mean = wave_sum(sum[r]) * (1.0f / D); float s2 = 0.f;
#pragma unroll
            for (int j = 0; j < 8; ++j) { y[r][j] = y[r][j] - mean; s2 += (y[r][j][0] * y[r][j][0] + y[r][j][1] * y[r][j][1]) + (y[r][j][2] * y[r][j][2] + y[r][j][3] * y[r][j][3]); }
            rstd[r] = 1.0f / sqrtf(wave_sum(s2) * (1.0f / D) + LN_EPS); }
#pragma unroll
        for (int hh = 0; hh < 2; ++hh) {
            f32x4 g2[4], bb2[4], s02[4], s12[4];
            if (hh == 0) {
#pragma unroll
                for (int j = 0; j < 4; ++j) { g2[j] = *((const f32x4*)lng + lane + 64 * (j + 4)); bb2[j] = *((const f32x4*)lnb + lane + 64 * (j + 4)); s02[j] = shp[64 * (j + 4)]; s12[j] = shp[64 * (j + 4) + D / 4]; }
                __builtin_amdgcn_sched_barrier(0);
            }
#pragma unroll
            for (int jj = 0; jj < 4; ++jj)
#pragma unroll
                for (int r = 0; r < R; ++r) { const int j = 4 * hh + jj; const f32x4 xn = y[r][j] * rstd[r] * g[jj] + bb[jj];
                    if (XOUT_BF) { u32x2 w; w.x = cvt_pk_bf16(xn[0], xn[1]); w.y = cvt_pk_bf16(xn[2], xn[3]); ((u32x2*)((bf16*)xout + (size_t)(m0 + r) * D) + lane)[64 * j] = w; } else ((f32x4*)((float*)xout + (size_t)(m0 + r) * D) + lane)[64 * j] = xn;
                    const f32x4 hf = xn * (1.0f + s1[jj]) + s0[jj];
                    if (H_I8) { y[r][j] = hf; }
                    else { u32x2 w; w.x = cvt_pk_bf16(hf[0], hf[1]); w.y = cvt_pk_bf16(hf[2], hf[3]); ((u32x2*)(hout + (size_t)(m0 + r) * D) + lane)[64 * j] = w; } }
            if (hh == 0) {
#pragma unroll
                for (int j = 0; j < 4; ++j) { g[j] = g2[j]; bb[j] = bb2[j]; s0[j] = s02[j]; s1[j] = s12[j]; } }
        }
        if (H_I8) {
#pragma unroll
            for (int r = 0; r < R; ++r) { float amax = 0.f;
#pragma unroll
                for (int j = 0; j < 8; ++j) amax = fmaxf(amax, fmaxf(fmaxf(fabsf(y[r][j][0]), fabsf(y[r][j][1])), fmaxf(fabsf(y[r][j][2]), fabsf(y[r][j][3]))));
#pragma unroll
                for (int o = 1; o < 64; o <<= 1) amax = fmaxf(amax, __shfl_xor(amax, o));
                amax = fmaxf(amax, 1e-20f); const float q = 127.0f / amax;
                if (lane == 0) rs[m0 + r] = amax * (1.0f / 127.0f);
#pragma unroll
                for (int j = 0; j < 8; ++j) ((unsigned*)((unsigned char*)hout + (size_t)(m0 + r) * D) + lane)[64 * j] = cvt_pk4_i8(y[r][j][0] * q, y[r][j][1] * q, y[r][j][2] * q, y[r][j][3] * q); }
        }
    }
}

template <bool MOE_IN, bool HAS_NEXT, bool ROUTER, bool XIN_BF, bool XOUT_BF>
__device__ __forceinline__ void ln_phase_row(const void* xin, void* xout, const bf16* O, const bf16* O2, const float* gate_mod  , const float* lng, const float* lnb,
                                         const float* next_mod, bf16* hout, const float* router_w, float* rs, unsigned char* meta, LAS unsigned char* lds, int gw, int NGW, int tid, int lane) {
    LAS float* rw = (LAS float*)lds;
    LAS f32x4* P = (LAS f32x4*)(lds + 65536);
    constexpr int RPW = 4;
    const int mb = gw * RPW, b = mb / SEQ;
    (void)NGW;
    if (ROUTER) { for (int i = tid; i < D * NE / 4; i += 512) ((LAS f32x4*)rw)[i] = ((const f32x4*)router_w)[i]; }
    { P[tid] = ((const f32x4*)lng)[tid]; P[512 + tid] = ((const f32x4*)lnb)[tid];
      if (HAS_NEXT) { const f32x4* sh = (const f32x4*)(next_mod + (size_t)b * 3 * D); P[1024 + tid] = sh[tid]; P[1536 + tid] = sh[tid + D / 4] + 1.0f; }
      P[2048 + tid] = ((const f32x4*)(gate_mod + (size_t)b * 3 * D + 2 * D))[tid] + 1.0f; }
    __syncthreads();
    u32x2 xw[2][8], ow[2][8]; f32x4 xf[2][8];
#define LN_XPRE(buf, row) do { _Pragma("unroll") for (int j = 0; j < 8; ++j) { \
        if (XIN_BF) xw[buf][j] = ((const u32x2*)((const bf16*)xin + (size_t)(row) * D) + lane)[64 * j]; else xf[buf][j] = ((const f32x4*)((const float*)xin + (size_t)(row) * D) + lane)[64 * j]; \
        ow[buf][j] = ((const u32x2*)(O + (size_t)(row) * D) + lane)[64 * j]; } } while (0)
    if (!MOE_IN) LN_XPRE(0, mb);
#pragma unroll
    for (int k = 0; k < RPW; ++k) { const int m = mb + k;
        f32x4 y[8];
        if (MOE_IN) {
            const int p1 = ((const int*)(meta + META_POS))[2 * m], p2 = ((const int*)(meta + META_POS))[2 * m + 1];
            const f32x2 pr = ((const f32x2*)(meta + META_TOKP))[m];
            const bool t1 = p1 >= 2 * M, t2 = p2 >= 2 * M;
            const u32x2* y1 = t1 ? (const u32x2*)(O2 + (size_t)(p1 - 2 * M) * D) + lane : (const u32x2*)(O + (size_t)p1 * D) + lane;
            const u32x2* y2 = t2 ? (const u32x2*)(O2 + (size_t)(p2 - 2 * M) * D) + lane : (const u32x2*)(O + (size_t)p2 * D) + lane;
            constexpr size_t SL4 = SLAB_ELEMS / 4;
            u32x2 w1[8], w2[8], xv[8];
#pragma unroll
            for (int j = 0; j < 8; ++j) { xv[j] = ((const u32x2*)((const bf16*)xin + (size_t)m * D) + lane)[64 * j]; w1[j] = y1[64 * j]; w2[j] = y2[64 * j]; }
            __builtin_amdgcn_sched_barrier(0);
#pragma unroll
            for (int j = 0; j < 8; ++j) { f32x4 a1 = bf4(w1[j]), a2 = bf4(w2[j]);
                if (t1) a1 = (a1 + bf4(y1[64 * j + SL4])) + (bf4(y1[64 * j + 2 * SL4]) + bf4(y1[64 * j + 3 * SL4]));
                if (t2) a2 = (a2 + bf4(y2[64 * j + SL4])) + (bf4(y2[64 * j + 2 * SL4]) + bf4(y2[64 * j + 3 * SL4]));
                y[j] = DN_ALPHA * bf4(xv[j]) + P[2048 + lane + 64 * j] * (pr.x * a1 + pr.y * a2); }
        } else {
            if (k + 1 < RPW) { LN_XPRE((k + 1) & 1, m + 1); __builtin_amdgcn_sched_barrier(0); }
#pragma unroll
            for (int j = 0; j < 8; ++j) y[j] = DN_ALPHA * (XIN_BF ? bf4(xw[k & 1][j]) : xf[k & 1][j]) + P[2048 + lane + 64 * j] * bf4(ow[k & 1][j]);
        }
        float s = 0.f;
#pragma unroll
        for (int j = 0; j < 8; ++j) s += (y[j][0] + y[j][1]) + (y[j][2] + y[j][3]);
        const float mean = wave_sum(s) * (1.0f / D); float s2 = 0.f;
#pragma unroll
        for (int j = 0; j < 8; ++j) { y[j] = y[j] - mean; s2 += (y[j][0] * y[j][0] + y[j][1] * y[j][1]) + (y[j][2] * y[j][2] + y[j][3] * y[j][3]); }
        const float rstd = 1.0f / sqrtf(wave_sum(s2) * (1.0f / D) + LN_EPS);
        f32x4* xo = (f32x4*)((float*)xout + (size_t)m * D) + lane; u32x2* xob = (u32x2*)((bf16*)xout + (size_t)m * D) + lane;
        float lg[NE];
#pragma unroll
        for (int e = 0; e < NE; ++e) lg[e] = 0.f;
#pragma unroll
        for (int j = 0; j < 8; ++j) { const f32x4 xn = y[j] * rstd * P[lane + 64 * j] + P[512 + lane + 64 * j];
            if (XOUT_BF) { u32x2 w; w.x = cvt_pk_bf16(xn[0], xn[1]); w.y = cvt_pk_bf16(xn[2], xn[3]); xob[64 * j] = w; } else xo[64 * j] = xn;
            if (HAS_NEXT) { const f32x4 hf = xn * P[1536 + lane + 64 * j] + P[1024 + lane + 64 * j];
                if (ROUTER) ((unsigned*)((unsigned char*)hout + (size_t)m * D) + lane)[64 * j] = cvt_pk4_fp8(hf[0] * F8_SA1, hf[1] * F8_SA1, hf[2] * F8_SA1, hf[3] * F8_SA1);
                else y[j] = hf;
                if (ROUTER) {
#pragma unroll
                    for (int q = 0; q < 4; ++q) { const int kk = 4 * lane + 256 * j + q; const f32x4 r0 = *(const LAS f32x4*)(rw + kk * 8), r1 = *(const LAS f32x4*)(rw + kk * 8 + 4);
                        lg[0] += hf[q] * r0[0]; lg[1] += hf[q] * r0[1]; lg[2] += hf[q] * r0[2]; lg[3] += hf[q] * r0[3]; lg[4] += hf[q] * r1[0]; lg[5] += hf[q] * r1[1]; lg[6] += hf[q] * r1[2]; lg[7] += hf[q] * r1[3]; } } } }
        if (HAS_NEXT && !ROUTER) {
            float amax = 0.f;
#pragma unroll
            for (int j = 0; j < 8; ++j) amax = fmaxf(amax, fmaxf(fmaxf(fabsf(y[j][0]), fabsf(y[j][1])), fmaxf(fabsf(y[j][2]), fabsf(y[j][3]))));
#pragma unroll
            for (int o = 1; o < 64; o <<= 1) amax = fmaxf(amax, __shfl_xor(amax, o));
            amax = fmaxf(amax, 1e-20f); const float q = 127.0f / amax;
            if (lane == 0) rs[m] = amax * (1.0f / 127.0f);
#pragma unroll
            for (int j = 0; j < 8; ++j) ((unsigned*)((unsigned char*)hout + (size_t)m * D) + lane)[64 * j] = cvt_pk4_i8(y[j][0] * q, y[j][1] * q, y[j][2] * q, y[j][3] * q);
        }
        if (ROUTER) {
#pragma unroll
            for (int e = 0; e < NE; ++e) lg[e] = wave_sum(lg[e]);
            int e1 = 0; float v1 = lg[0];
#pragma unroll
            for (int e = 1; e < NE; ++e) if (lg[e] > v1) { v1 = lg[e]; e1 = e; }
            int e2 = -1; float v2 = -3.0e38f;
#pragma unroll
            for (int e = 0; e < NE; ++e) if (e != e1 && lg[e] > v2) { v2 = lg[e]; e2 = e; }
            const float ex = __expf(v2 - v1), p1 = 1.0f / (1.0f + ex), p2 = ex / (1.0f + ex);
            if (lane == 0) { ((unsigned*)(meta + META_TOKE))[m] = (unsigned)e1 | ((unsigned)e2 << 8); ((f32x2*)(meta + META_TOKP))[m] = (f32x2){p1, p2}; }
        }
    }
}
#undef LN_XPRE

__device__ __forceinline__ void moe_scatter(const bf16* H, bf16* HS, unsigned char* meta, LAS unsigned char* lds, int bid, int G, int tid, int wave, int lane) {
    LAS unsigned* cnt = (LAS unsigned*)lds;
    LAS int* spos = (LAS int*)(lds + 256);
    LAS int* sbase = (LAS int*)(lds + 1024);
    const unsigned* toke = (const unsigned*)(meta + META_TOKE);
    const int TPW = M / G, blk0 = bid * TPW;
    if (tid < 16) cnt[tid] = 0u;
    __syncthreads();
    { unsigned tot[NE], bef[NE];
#pragma unroll
      for (int e = 0; e < NE; ++e) { tot[e] = 0u; bef[e] = 0u; }
      const int tk0 = tid * 16;
#pragma unroll
      for (int q = 0; q < 4; ++q) { const u32x4 v = *((const u32x4*)(toke + tk0) + q);
#pragma unroll
          for (int j = 0; j < 4; ++j) { const unsigned w = v[j], e1 = w & 0xffu, e2 = (w >> 8) & 0xffu; const bool bf = (tk0 + 4 * q + j) < blk0;
#pragma unroll
              for (int e = 0; e < NE; ++e) { const unsigned hit = (e1 == (unsigned)e) + (e2 == (unsigned)e); tot[e] += hit; bef[e] += bf ? hit : 0u; } } }
#pragma unroll
      for (int e = 0; e < NE; ++e) { unsigned t = tot[e], b2 = bef[e];
#pragma unroll
          for (int o = 1; o < 64; o <<= 1) { t += __shfl_xor(t, o); b2 += __shfl_xor(b2, o); }
          tot[e] = t; bef[e] = b2; }
      if (lane == 0) {
#pragma unroll
          for (int e = 0; e < NE; ++e) { atomicAdd((unsigned*)&cnt[e], tot[e]); atomicAdd((unsigned*)&cnt[8 + e], bef[e]); } }
    }
    __syncthreads();
    if (tid == 0) { int base = 0; for (int e = 0; e < NE; ++e) { sbase[e] = base; sbase[8 + e] = (int)cnt[e]; base += (((int)cnt[e] + 255) >> 8) << 8; } }
    __syncthreads();
    if (wave == 0) {
        const bool act = lane < TPW; const unsigned w = act ? toke[blk0 + lane] : 0xffffu; const unsigned e1 = w & 0xffu, e2 = (w >> 8) & 0xffu;
        int pos1 = 0, pos2 = 0;
#pragma unroll
        for (int e = 0; e < NE; ++e) { const unsigned long long mk = __ballot(act && (e1 == (unsigned)e || e2 == (unsigned)e)); const int rank = __popcll(mk & ((1ull << lane) - 1ull));
            const int p = sbase[e] + (int)cnt[8 + e] + rank; if (e1 == (unsigned)e) pos1 = p; if (e2 == (unsigned)e) pos2 = p; }
        if (act) { spos[2 * lane] = pos1; spos[2 * lane + 1] = pos2; ((int*)(meta + META_POS))[2 * (blk0 + lane)] = pos1; ((int*)(meta + META_POS))[2 * (blk0 + lane) + 1] = pos2; }
    }
    __syncthreads();
#pragma unroll 1
    for (int c0 = wave; c0 < 2 * TPW; c0 += 32) { u32x4 v[4][2];
#pragma unroll
        for (int q = 0; q < 4; ++q) { const int cpy = c0 + 8 * q; const int tk = blk0 + (cpy >> 1); const u32x4* sp = (const u32x4*)((const unsigned char*)H + (size_t)tk * D) + lane;
            if (cpy < 2 * TPW) { v[q][0] = sp[0]; v[q][1] = sp[64]; } }
#pragma unroll
        for (int q = 0; q < 4; ++q) { const int cpy = c0 + 8 * q;
            if (cpy < 2 * TPW) { u32x4* d = (u32x4*)((unsigned char*)HS + (size_t)spos[cpy] * D) + lane; d[0] = v[q][0]; d[64] = v[q][1]; } } }
    for (int e = 0; e < NE; ++e) { const int c = sbase[8 + e], r = c + bid, rend = ((c + 255) >> 8) << 8;
        if (r < rend) { unsigned* d = (unsigned*)((unsigned char*)HS + (size_t)(sbase[e] + r) * D); d[tid] = 0u; } }
    if (bid == 0 && tid == 0) { int* mi = (int*)(meta + META_INTS); int tb = 0; for (int e = 0; e < NE; ++e) { mi[e] = tb; tb += (sbase[8 + e] + 255) >> 8; } mi[8] = tb; }
}

__global__ void __launch_bounds__(512, 2) fwd(Args args) {
    extern __shared__ __attribute__((aligned(16))) unsigned char lds_raw[];
    LAS unsigned char* lds = (LAS unsigned char*)lds_raw;
    unsigned char* ws = args.ws;
    volatile LAS unsigned* MISC = (volatile LAS unsigned*)(lds + LDSCTL_OFF);
    if (threadIdx.x < 64) MISC[threadIdx.x] = 0u;
    const int wave0 = __builtin_amdgcn_readfirstlane((int)threadIdx.x >> 6);
    __syncthreads();
#define IDS() int wave = wave0; asm volatile("" : "+s"(wave)); int bid = blockIdx.x; asm volatile("" : "+s"(bid)); const int G = gridDim.x; \
    const int lane = lane_id_fresh(); const int tid = wave * 64 + lane; const int vcu = (G % 8 == 0) ? (bid % 8) * (G / 8) + bid / 8 : bid; const int gw = vcu * 8 + wave, NGW = G * 8; \
    (void)lane; (void)wave; (void)vcu; (void)gw; (void)NGW; (void)bid; (void)G
    const int lo = args.ph_lo, hi = args.ph_hi;
    XcdBarrier bar; bar.bar = (unsigned*)(ws + WS_CTL) + CW_BAR; bar.x = 0; bar.st = nullptr;
    if (hi - lo > 1) bar = xcd_barrier_post((unsigned*)(ws + WS_CTL) + CW_BAR, MISC + 8);
#ifndef PH_MASK
#define PH_MASK 0xffffffffu
#endif
#define IN(k) (((PH_MASK >> (k)) & 1u) && lo <= (k) && (k) < hi)
#define SEAM(k) do { if (IN((k) + 1)) xcd_barrier(bar, wave0); } while (0)

    float* mod = (float*)(ws + WS_MOD);
    float* X = (float*)(ws + WS_X); bf16* H = (bf16*)(ws + WS_H); bf16* O = (bf16*)(ws + WS_O);
    bf16* Z = (bf16*)(ws + WS_Z); bf16* XC = (bf16*)(ws + WS_XC); bf16* PP = (bf16*)(ws + WS_PP); float* Aa = (float*)(ws + WS_A); float* Uu = (float*)(ws + WS_U); bf16* YCAT = (bf16*)(ws + WS_YCAT);
    unsigned char* meta = ws + WS_META;

    if (IN(0)) { IDS();
        if (bid == G - 1) { for (int i = tid; i < 2 * DLRU; i += 512) { const float t = -args.in[IN_LAM][i]; ((float*)(ws + WS_SP))[i] = -8.0f * (fmaxf(t, 0.f) + log1pf(__expf(-fabsf(t)))); } }
        p0_adaln(args, ws, lds, vcu, G, tid, wave, lane); __syncthreads(); convert_items_bf16(args, ws, lds, 0, T_FD, gw, NGW, wave, lane); convert_items(args, ws, lds, T_FD, T_IN, gw, NGW, wave, lane); p0_absmax(args, (unsigned*)(ws + WS_CTL) + CW_AMAX, lds, gw, NGW, tid, lane); __syncthreads(); SEAM(0); }
    if (IN(1)) { IDS(); p1_mod_rows(args.in[IN_X], mod, H, (float*)(meta + META_RS), gw, NGW, lane); convert_items(args, ws, lds, T_IN, T_FG, gw, NGW, wave, lane); SEAM(1); }


#define MIXER(l, pb) \
        if (IN(pb + 0)) { IDS(); \
            if (bid >= CV_P2_WGS) { convert_items(args, ws, lds, l == 0 ? CV_A0 : CV_B1, l == 0 ? CV_A1 : CV_C1, (bid - CV_P2_WGS) * 8 + wave, (G - CV_P2_WGS) * 8, wave, lane); __syncthreads(); } else { \
            pg8::PlainSched S; S.init_order(M / 256, DIN / 256, CV_P2_WGS, bid); S.A = (const char*)H; S.B = (const char*)(ws + WS_WIN) + (size_t)l * DIN * D; S.a_tile = (size_t)256 * D; S.b_tile = (size_t)256 * D; S.a_sh = 0; S.a_mul = 0u;     \
            pg8::EpiBf16I8 E{Z, DIN, (const float*)(meta + META_RS), (const unsigned*)(ws + WS_CTL) + CW_AMAX + 1 + l}; \
            pg8::gemm_phase<pg8::EpiBf16I8, pg8::PlainSched, 2>(lds, pg8::Gemm{D / 2, D / 2, D / 2}, S, E, wave); } \
            SEAM(pb + 0); \
        } \
          \
        if (IN(pb + 2)) { IDS(); \
            if (bid < G / 2) { const int pmq = bid >> 2, hq = bid & 3; \
              conv_tile(Z, args.in[IN_CONVW] + l * 4 * DLRU, args.in[IN_CONVB] + l * DLRU, XC, pmq, hq, tid); \
              asm volatile("s_waitcnt vmcnt(0)" ::: "memory"); __syncthreads(); \
              pg8::FixedSched S; S.pm = pmq; S.pn0 = 2 * hq; S.n = 2; S.A = (const char*)XC; S.B = (const char*)(ws + WS_WG) + (size_t)l * 2048 * 256 * 2; S.a_tile = (size_t)256 * DLRU * 2; S.b_tile = (size_t)256 * 256 * 2; S.a_sh = 1; S.a_mul = 512u; \
              pg8::EpiGates E{args.in[IN_BA] + l * DLRU, args.in[IN_BX] + l * DLRU, (const float*)(ws + WS_SP) + l * DLRU, XC, (unsigned*)Aa}; \
              pg8::gemm_phase<pg8::EpiGates, pg8::FixedSched>(lds, pg8::Gemm{DLRU, 256, 256}, S, E, wave); } \
            else { const int wq = bid - G / 2, pmq = wq >> 2, gq = wq & 3; \
              pool_tile(Z, PP, pmq, gq, tid); \
              asm volatile("s_waitcnt vmcnt(0)" ::: "memory"); __syncthreads(); \
              pg8::FixedSched S; S.pm = pmq; S.pn0 = gq; S.n = 1; S.A = (const char*)PP; S.B = (const char*)(ws + WS_WP) + (size_t)l * 1024 * 256 * 2; S.a_tile = (size_t)256 * DLRU * 2; S.b_tile = (size_t)256 * 256 * 2; S.a_sh = 0; S.a_mul = 512u; \
              pg8::EpiPool E{YCAT, D, DLRU, args.in[IN_POOLB] + l * DLRU, args.in[IN_POOLS] + l * DLRU}; \
              pg8::gemm_phase<pg8::EpiPool, pg8::FixedSched>(lds, pg8::Gemm{DLRU, 256, 256}, S, E, wave); } \
            SEAM(pb + 2); \
        } \
        if (IN(pb + 3)) { IDS(); p5_scan((const unsigned*)Aa, Z, YCAT, lds, vcu, G, tid); SEAM(pb + 3); } \
        if (IN(pb + 4)) { IDS(); \
            pg8::PlainSched S; S.init_order(M / 256, D / 256, G, bid); S.A = (const char*)YCAT; S.B = (const char*)(ws + WS_WOUT) + (size_t)l * D * D * 2; S.a_tile = (size_t)256 * D * 2; S.b_tile = (size_t)256 * D * 2; S.a_sh = 0; S.a_mul = 0u; \
            if (l == 0) {   \
              pg8::EpiLnFusedT<false> E{args.in[IN_X], (bf16*)X, (unsigned char*)H, (float*)(meta + META_RS), mod + (size_t)0 * 4 * 3 * D + 2 * D, args.in[IN_LNG] + 0 * D, args.in[IN_LNB] + 0 * D, mod + (size_t)1 * 4 * 3 * D, mod + (size_t)1 * 4 * 3 * D + D, \
                                 (unsigned long long*)(ws + WS_O), (unsigned*)(ws + WS_O + 1048576), (unsigned*)(ws + WS_CTL) + CW_LNC, (unsigned*)(ws + WS_CTL) + CW_LNC + 2048, lds}; \
              pg8::gemm_phase<pg8::EpiLnFusedT<false>, pg8::PlainSched>(lds, pg8::Gemm{D, D, D}, S, E, wave); \
            } else {   \
              pg8::EpiLnRouter E{(bf16*)X, (unsigned char*)H, mod + (size_t)2 * 4 * 3 * D + 2 * D, args.in[IN_LNG] + 2 * D, args.in[IN_LNB] + 2 * D, mod + (size_t)3 * 4 * 3 * D, mod + (size_t)3 * 4 * 3 * D + D, args.in[IN_ROUTER], (unsigned*)(meta + META_TOKE), (f32x2*)(meta + META_TOKP), \
                                  (unsigned long long*)(ws + WS_O), (unsigned long long*)(ws + WS_O + 1048576), (unsigned*)(ws + WS_CTL) + CW_LNC + 4096, (unsigned*)(ws + WS_CTL) + CW_LNC + 4096 + 2048, lds}; \
              pg8::gemm_phase<pg8::EpiLnRouter, pg8::PlainSched>(lds, pg8::Gemm{D, D, D}, S, E, wave); } \
            SEAM(pb + 4); \
        }

    MIXER(0, 2)
    if (IN(8)) { IDS();
        if (bid >= CV_P8_WGS) { convert_items(args, ws, lds, CV_A1, CV_B1, (bid - CV_P8_WGS) * 8 + wave, (G - CV_P8_WGS) * 8, wave, lane); __syncthreads(); } else {
        pg8::PlainSched S; S.init_order(M / 256, 2 * DFF / 256, CV_P8_WGS, bid); S.A = (const char*)H; S.B = (const char*)(ws + WS_WGU); S.a_tile = (size_t)256 * D; S.b_tile = (size_t)256 * D; S.a_sh = 0; S.a_mul = 0u;
        pg8::EpiSwigluI8F8 E{(bf16*)(ws + WS_HID), DFF, (const float*)(meta + META_RS), (const unsigned*)(ws + WS_CTL) + CW_AMAX};
        pg8::gemm_phase<pg8::EpiSwigluI8F8, pg8::PlainSched, 2>(lds, pg8::Gemm{D / 2, D / 2, D / 2}, S, E, wave); }
        SEAM(8);
    }
    if (IN(9)) { IDS();
        pg8::PlainSched S; S.init_order(M / 256, D / 256, G, bid); S.A = (const char*)(ws + WS_HID); S.B = (const char*)(ws + WS_WD); S.a_tile = (size_t)256 * DFF; S.b_tile = (size_t)256 * DFF; S.a_sh = 0; S.a_mul = 0u;
        pg8::EpiLnFusedB E{(const float*)X, (bf16*)X, (unsigned char*)H, (float*)(meta + META_RS), mod + (size_t)1 * 4 * 3 * D + 2 * D, args.in[IN_LNG] + 1 * D, args.in[IN_LNB] + 1 * D, mod + (size_t)2 * 4 * 3 * D, mod + (size_t)2 * 4 * 3 * D + D,
                            (unsigned long long*)(ws + WS_O), (unsigned*)(ws + WS_O + 1048576), (unsigned*)(ws + WS_CTL) + CW_LNC2, (unsigned*)(ws + WS_CTL) + CW_LNC2 + 2048, lds};
        pg8::gemm_phase<pg8::EpiLnFusedB, pg8::PlainSched, 1>(lds, pg8::Gemm{DFF / 2, DFF / 2, DFF / 2}, S, E, wave);
        SEAM(9);
    }
    MIXER(1, 11)
    if (IN(17)) { IDS(); moe_scatter(H, (bf16*)(ws + WS_HS), meta, lds, bid, G, tid, wave, lane); __syncthreads(); { LAS int* sb = (LAS int*)(lds + 1024); int T = 0;
#pragma unroll
          for (int e = 0; e < NE; ++e) T += (sb[8 + e] + 255) >> 8;
          const int nsp = __builtin_amdgcn_readfirstlane(moe_spare_wgs(T));
          convert_items(args, ws, lds, T_LATE + nsp * LATE_K, T_END, gw, NGW, wave, lane); }
        __syncthreads(); SEAM(17); }
    if (IN(18)) { IDS();
        int tbv[9];
#pragma unroll
        for (int e = 0; e < 9; ++e) tbv[e] = __builtin_amdgcn_readfirstlane((int)__hip_atomic_load((unsigned*)(meta + META_INTS) + e, __ATOMIC_RELAXED, __HIP_MEMORY_SCOPE_AGENT));
        const int nsp = moe_spare_wgs(tbv[8]), Gg = G - nsp;
        if (bid >= Gg) { convert_items(args, ws, lds, T_LATE + (bid - Gg) * LATE_K, T_LATE + (bid - Gg + 1) * LATE_K, wave, 8, wave, lane); __syncthreads(); } else {
        pg8::MoeSched S; S.init_order(tbv[8], 2 * DFE / 256, Gg, bid); S.A = (const char*)(ws + WS_HS); S.B = (const char*)(ws + WS_WEGU); S.a_tile = (size_t)256 * D; S.b_tile = (size_t)256 * D; S.b_exp = (size_t)2 * DFE * D;
        S.tb1 = tbv[1]; S.tb2 = tbv[2]; S.tb3 = tbv[3]; S.tb4 = tbv[4]; S.tb5 = tbv[5]; S.tb6 = tbv[6]; S.tb7 = tbv[7];
        pg8::EpiSwigluF8 E{ws + WS_HIDS, DFE, 1.0f / (F8_SA1 * F8_SB1), F8_SH};
        pg8::gemm_phase<pg8::EpiSwigluF8, pg8::MoeSched, 1>(lds, pg8::Gemm{D / 2, D / 2, D / 2}, S, E, wave); }
        SEAM(18);
    }
    if (IN(19)) { IDS();
        int tbv[9];
#pragma unroll
        for (int e = 0; e < 9; ++e) tbv[e] = __builtin_amdgcn_readfirstlane((int)__hip_atomic_load((unsigned*)(meta + META_INTS) + e, __ATOMIC_RELAXED, __HIP_MEMORY_SCOPE_AGENT));
        const int Tm = tbv[8] < 64 ? tbv[8] : 64;
        { pg8::MoeSched S; S.init_order(Tm, D / 256, G, bid); S.A = (const char*)(ws + WS_HIDS); S.B = (const char*)(ws + WS_WED); S.a_tile = (size_t)256 * DFE; S.b_tile = (size_t)256 * DFE; S.b_exp = (size_t)D * DFE;
          S.tb1 = tbv[1]; S.tb2 = tbv[2]; S.tb3 = tbv[3]; S.tb4 = tbv[4]; S.tb5 = tbv[5]; S.tb6 = tbv[6]; S.tb7 = tbv[7];
          pg8::EpiBf16 E{(bf16*)(ws + WS_YBUF), D, 0, 0, 1.0f / (F8_SH * F8_SB2)};
          pg8::gemm_phase<pg8::EpiBf16, pg8::MoeSched, 1>(lds, pg8::Gemm{DFE / 2, DFE / 2, DFE / 2}, S, E, wave); }
        if (tbv[8] > 64) {
          pg8::MoeTailSched S; S.pm0 = 64; S.nsub = (tbv[8] - 64) * 8 * 4; S.G = G; S.c = bid; S.A = (const char*)(ws + WS_HIDS); S.B = (const char*)(ws + WS_WED); S.a_tile = (size_t)256 * DFE; S.b_tile = (size_t)256 * DFE; S.b_exp = (size_t)D * DFE; S.kslice = (size_t)(DFE / 4); S.bslice = (size_t)(DFE / 4) * 256;
          S.tb1 = tbv[1]; S.tb2 = tbv[2]; S.tb3 = tbv[3]; S.tb4 = tbv[4]; S.tb5 = tbv[5]; S.tb6 = tbv[6]; S.tb7 = tbv[7];
          pg8::EpiBf16 E{(bf16*)(ws + WS_SLAB), D, SLAB_ELEMS, 64, 1.0f / (F8_SH * F8_SB2)};
          pg8::gemm_phase<pg8::EpiBf16, pg8::MoeTailSched, 1>(lds, pg8::Gemm{DFE / 2, DFE / 2, DFE / 8}, S, E, wave); }
        SEAM(19);
    }
    if (IN(20)) { IDS();
        ln_phase_row<true, false, false, true, false>(X, args.out, (const bf16*)(ws + WS_YBUF), (const bf16*)(ws + WS_SLAB), mod + (size_t)3 * 4 * 3 * D, args.in[IN_LNG] + 3 * D, args.in[IN_LNB] + 3 * D, nullptr, nullptr, nullptr, nullptr, meta, lds, gw, NGW, tid, lane);
    }
#undef MIXER
#undef IN
#undef SEAM
}

extern "C" void kernel_launch(void* const* d_in, const int* in_sizes, int n_in, void* d_out, int out_size, void* d_ws, size_t ws_size, hipStream_t stream) {
    static int grid = 0;
    if (grid == 0) {
        if (n_in != 25 || out_size != M * D || ws_size < WS_END) { fprintf(stderr, "kernel_launch: unexpected sizes (n_in %d, out %d, ws %zu < %zu)\n", n_in, out_size, ws_size, (size_t)WS_END); grid = -1; return; }
        if (hipFuncSetAttribute((const void*)fwd, hipFuncAttributeMaxDynamicSharedMemorySize, LDS_BYTES) != hipSuccess) { fprintf(stderr, "kernel_launch: hipFuncSetAttribute failed\n"); grid = -1; return; }
        int dev = 0, cus = 0, per_cu = 0;
        (void)hipGetDevice(&dev); (void)hipDeviceGetAttribute(&cus, hipDeviceAttributeMultiprocessorCount, dev);
        if (hipOccupancyMaxActiveBlocksPerMultiprocessor(&per_cu, (const void*)fwd, 512, LDS_BYTES) != hipSuccess || per_cu < 1) fprintf(stderr, "kernel_launch: occupancy query reports %d\n", per_cu);
        (void)hipGetLastError();
        grid = 256;
        if (cus != 256) fprintf(stderr, "kernel_launch: device reports %d CUs; this kernel is built for 256\n", cus);
    }
    if (grid < 0) return;
    (void)hipMemsetAsync((char*)d_ws + WS_CTL, 0, CTL_ZERO_BYTES, stream);
    Args a{};
    for (int i = 0; i < 25; ++i) a.in[i] = (const float*)d_in[i];
    a.out = (float*)d_out; a.ws = (unsigned char*)d_ws;
#if MK_ONE_LAUNCH
    a.ph_lo = 0; a.ph_hi = NPHASE;
    hipLaunchKernelGGL(fwd, dim3(grid), dim3(512), LDS_BYTES, stream, a);
#else
#ifndef DUP_MASK
#define DUP_MASK 0u
#endif
    for (int p = 0; p < NPHASE; ++p) { a.ph_lo = p; a.ph_hi = p + 1; const int reps = ((DUP_MASK >> p) & 1u) ? 2 : 1;
        for (int r = 0; r < reps; ++r) hipLaunchKernelGGL(fwd, dim3(grid), dim3(512), LDS_BYTES, stream, a); }
#endif
}
```
